# Optimizing an MI355X kernel written in HIP

```python
import math
import jax, jax.numpy as jnp
from jax import lax
import numpy as np

D_MODEL = 2048
BATCH = 8
SEQ = 2048
DEPTH = 1

GRID_W = 64
CTX_LEN = 256
MIX_WIDTH = D_MODEL
DA_WIDTH = MIX_WIDTH // 2
HG_WIDTH = MIX_WIDTH - DA_WIDTH
DA_HEAD_V = 128
DA_HEADS = DA_WIDTH // DA_HEAD_V
DA_HEAD_QK = DA_HEAD_V // 2
HG_EXPAND = 128
HG_HEADS = HG_WIDTH // HG_EXPAND
HG_HEAD_I = HG_WIDTH // HG_HEADS
IN_WIDTH = 3 * DA_WIDTH + 5 * HG_WIDTH
D_FF = 4 * D_MODEL
ROT_AXIS = DA_HEAD_QK // 2
ROPE_BASE = 10000.0
Q_BLOCK = 128
HG_CHUNK = 64
N_ADA = 6
EPS = 1e-5
ALPHA = (2.0 * DEPTH) ** 0.25
BETA = (8.0 * DEPTH) ** -0.25

kernel_name = 'hybrid_diffattn_hgrn2_dit_block'


def layer_norm(x, g, b):
    xf = x.astype(jnp.float32)
    mu = jnp.mean(xf, axis=-1, keepdims=True)
    var = jnp.mean(jnp.square(xf - mu), axis=-1, keepdims=True)
    return ((xf - mu) * lax.rsqrt(var + EPS) * g.astype(jnp.float32) + b.astype(jnp.float32)).astype(x.dtype)


def rms_norm(x, w):
    xf = x.astype(jnp.float32)
    return xf * lax.rsqrt(jnp.mean(xf * xf, axis=-1, keepdims=True) + EPS) * w.astype(jnp.float32)


def modulate(h, shift, scale):
    return h * (1 + scale) + shift


def adaln(cond, w, b):
    m = jax.nn.silu(cond) @ w + b
    return m.reshape(m.shape[0], N_ADA, D_MODEL)


def axial_rope_tables(rows):
    f32 = jnp.float32
    row = jnp.repeat(jnp.arange(rows, dtype=f32), GRID_W)
    col = jnp.tile(jnp.arange(GRID_W, dtype=f32), rows)
    inv_freq = ROPE_BASE ** (-jnp.arange(0, ROT_AXIS, 2, dtype=f32) / ROT_AXIS)
    ang_r = row[:, None] * inv_freq
    ang_c = col[:, None] * inv_freq
    return (jnp.cos(ang_r), jnp.sin(ang_r), jnp.cos(ang_c), jnp.sin(ang_c))


def rotate_pairs(x, cos, sin):
    x1, x2 = jnp.split(x, 2, axis=-1)
    return jnp.concatenate([x1 * cos - x2 * sin, x2 * cos + x1 * sin], axis=-1)


def apply_axial_rope(x, tables):
    cr, sr, cc, sc = [t[:, None, None, :] for t in tables]
    xr, xc = jnp.split(x.astype(jnp.float32), 2, axis=-1)
    return jnp.concatenate([rotate_pairs(xr, cr, sr), rotate_pairs(xc, cc, sc)], axis=-1).astype(x.dtype)


def split_projection(p):
    B, T, _ = p.shape
    sizes = [DA_WIDTH] * 3 + [HG_WIDTH] * 5
    offsets = [int(o) for o in np.cumsum(sizes)[:-1]]
    qd, kd, vd, qh, zf, zb, ih, gh = jnp.split(p, offsets, axis=-1)
    qd = qd.reshape(B, T, DA_HEADS, 2, DA_HEAD_QK)
    kd = kd.reshape(B, T, DA_HEADS, 2, DA_HEAD_QK)
    vd = vd.reshape(B, T, DA_HEADS, DA_HEAD_V)
    qh = jax.nn.silu(qh).reshape(B, T, HG_HEADS, HG_EXPAND)
    zf = zf.reshape(B, T, HG_HEADS, HG_EXPAND)
    zb = zb.reshape(B, T, HG_HEADS, HG_EXPAND)
    ih = ih.reshape(B, T, HG_HEADS, HG_HEAD_I)
    return qd, kd, vd, qh, zf, zb, ih, gh


def diff_attend(q, keys, vals, lam):
    B, Tq, H = q.shape[:3]
    nb = Tq // Q_BLOCK
    scale = DA_HEAD_QK ** -0.5
    qb = jnp.moveaxis(q.reshape(B, nb, Q_BLOCK, H, 2, DA_HEAD_QK), 1, 0)

    def block(qblk):
        s = jnp.einsum('bqhmd,bkhmd->bhmqk', qblk, keys, preferred_element_type=jnp.float32) * scale
        p = jax.nn.softmax(s, axis=-1)
        a = p[:, :, 0] - lam * p[:, :, 1]
        return jnp.einsum('bhqk,bkhv->bqhv', a.astype(vals.dtype), vals)

    o = lax.map(block, qb)
    return jnp.moveaxis(o, 0, 1).reshape(B, Tq, H, DA_HEAD_V)


def da_output(o, w, lam_init, dtype):
    B, T = o.shape[:2]
    return (rms_norm(o, w) * (1.0 - lam_init)).reshape(B, T, DA_WIDTH).astype(dtype)


def hgrn_gates(z, lb):
    zf = z.astype(jnp.float32)
    f = lb + (1.0 - lb) * jax.nn.sigmoid(zf)
    return jnp.log(f), (1.0 - lb) * jax.nn.sigmoid(-zf)


def hgrn2_chunk_scan(q, k, logf, v, s0):
    f32 = jnp.float32
    B, T, H, _ = q.shape
    nc = T // HG_CHUNK
    L = HG_CHUNK

    def to_chunks(a):
        return a.astype(f32).reshape(B, nc, L, H, a.shape[-1]).transpose(1, 0, 3, 2, 4)

    mask = jnp.tril(jnp.ones((L, L), dtype=bool))[:, :, None]

    def step(S, xs):
        qc, kc, gc, vc = xs
        b = jnp.cumsum(gc, axis=-2)
        rel = jnp.where(mask, b[:, :, :, None, :] - b[:, :, None, :, :], -jnp.inf)
        decay = jnp.exp(rel)
        intra = jnp.einsum('bhtd,bhsd,bhtsd->bhts', qc, kc, decay)
        o = jnp.einsum('bhts,bhsv->bhtv', intra, vc) + jnp.einsum('bhtd,bhdv->bhtv', qc * jnp.exp(b), S)
        b_last = b[:, :, -1:, :]
        S_new = jnp.exp(b_last[:, :, 0, :, None]) * S + jnp.einsum('bhsd,bhsv->bhdv', kc * jnp.exp(b_last - b), vc)
        return S_new, o

    S, o = lax.scan(step, s0, (to_chunks(q), to_chunks(k), to_chunks(logf), to_chunks(v)))
    o = o.transpose(1, 0, 3, 2, 4).reshape(B, T, H, v.shape[-1])
    return o, S


def hg_output(o, g, w, dtype):
    B, T = o.shape[:2]
    return (rms_norm(o, w).reshape(B, T, HG_WIDTH) * jax.nn.silu(g.astype(jnp.float32))).astype(dtype)


def finish_layer(h, mixed, gt1, sh2, sc2, gt2, w_out, ln1_g, ln1_b, w_ff1, w_ff2, ln2_g, ln2_b):
    y = mixed @ w_out
    h = layer_norm(ALPHA * h + gt1 * y, ln1_g, ln1_b)
    u = modulate(h, sh2, sc2)
    ff = jnp.square(jax.nn.relu(u @ w_ff1)) @ w_ff2
    return layer_norm(ALPHA * h + gt2 * ff, ln2_g, ln2_b)


def setup_inputs(seed: int = 0) -> dict:
    key = jax.random.key(seed)
    ks = jax.random.split(key, 22)
    f32 = jnp.float32

    def nrm(k, shape, std):
        return std * jax.random.normal(k, shape, f32)

    return {
        'x': nrm(ks[0], (BATCH, SEQ, D_MODEL), 1.0),
        'c': nrm(ks[1], (BATCH, D_MODEL), 1.0),
        'ctx': nrm(ks[2], (BATCH, CTX_LEN, D_MODEL), 1.0),
        'c_ctx': nrm(ks[3], (D_MODEL,), 1.0),
        'w_ada': nrm(ks[4], (DEPTH, D_MODEL, N_ADA * D_MODEL), 0.5 * D_MODEL ** -0.5),
        'b_ada': nrm(ks[5], (DEPTH, N_ADA * D_MODEL), 0.02),
        'w_in': nrm(ks[6], (DEPTH, D_MODEL, IN_WIDTH), D_MODEL ** -0.5),
        'lam_q1': nrm(ks[7], (DEPTH, DA_HEAD_QK), 0.1),
        'lam_k1': nrm(ks[8], (DEPTH, DA_HEAD_QK), 0.1),
        'lam_q2': nrm(ks[9], (DEPTH, DA_HEAD_QK), 0.1),
        'lam_k2': nrm(ks[10], (DEPTH, DA_HEAD_QK), 0.1),
        'da_norm_w': 1.0 + nrm(ks[11], (DEPTH, DA_HEAD_V), 0.02),
        'hg_lb_fwd': 1.0 + nrm(ks[12], (DEPTH + 1, HG_WIDTH), 0.1),
        'hg_lb_bwd': 1.0 + nrm(ks[13], (DEPTH + 1, HG_WIDTH), 0.1),
        'hg_norm_w': 1.0 + nrm(ks[14], (DEPTH, HG_HEAD_I), 0.02),
        'w_out': nrm(ks[15], (DEPTH, MIX_WIDTH, D_MODEL), BETA * MIX_WIDTH ** -0.5),
        'ln1_g': 1.0 + nrm(ks[16], (DEPTH, D_MODEL), 0.02),
        'ln1_b': nrm(ks[17], (DEPTH, D_MODEL), 0.02),
        'w_ff1': nrm(ks[18], (DEPTH, D_MODEL, D_FF), D_MODEL ** -0.5),
        'w_ff2': nrm(ks[19], (DEPTH, D_FF, D_MODEL), BETA * D_FF ** -0.5),
        'ln2_g': 1.0 + nrm(ks[20], (DEPTH, D_MODEL), 0.02),
        'ln2_b': nrm(ks[21], (DEPTH, D_MODEL), 0.02),
    }


def reference(x, c, ctx, c_ctx, w_ada, b_ada, w_in, lam_q1, lam_k1, lam_q2, lam_k2,
              da_norm_w, hg_lb_fwd, hg_lb_bwd, hg_norm_w, w_out, ln1_g, ln1_b,
              w_ff1, w_ff2, ln2_g, ln2_b):
    f32 = jnp.float32
    B, T, _ = x.shape
    rows = T // GRID_W
    rope = axial_rope_tables(rows)
    lb_fwd_all = jnp.cumsum(jax.nn.softmax(hg_lb_fwd.astype(f32), axis=0), axis=0)
    lb_bwd_all = jnp.cumsum(jax.nn.softmax(hg_lb_bwd.astype(f32), axis=0), axis=0)
    s0 = jnp.zeros((B, HG_HEADS, HG_EXPAND, HG_HEAD_I), f32)
    flip = lambda a: jnp.flip(a, axis=1)

    h, hc = x, ctx
    for l in range(DEPTH):
        lam_init = 0.8 - 0.6 * math.exp(-0.3 * l)
        lam = (jnp.exp(jnp.sum(lam_q1[l].astype(f32) * lam_k1[l].astype(f32)))
               - jnp.exp(jnp.sum(lam_q2[l].astype(f32) * lam_k2[l].astype(f32))) + lam_init)
        m = adaln(c, w_ada[l], b_ada[l])
        mc = adaln(c_ctx[None], w_ada[l], b_ada[l])
        sh1, sc1, gt1, sh2, sc2, gt2 = [m[:, j, None, :] for j in range(N_ADA)]
        csh1, csc1, cgt1, csh2, csc2, cgt2 = [mc[:, j, None, :] for j in range(N_ADA)]

        qd, kd, vd, qh, zf, zb, ih, gh = split_projection(modulate(h, sh1, sc1) @ w_in[l])
        qd_c, kd_c, vd_c, qh_c, zf_c, zb_c, ih_c, gh_c = split_projection(modulate(hc, csh1, csc1) @ w_in[l])

        qd = apply_axial_rope(qd, rope)
        kd = apply_axial_rope(kd, rope)
        keys = jnp.concatenate([kd, kd_c], axis=1)
        vals = jnp.concatenate([vd, vd_c], axis=1)
        o_da = da_output(diff_attend(qd, keys, vals, lam), da_norm_w[l], lam_init, h.dtype)

        lbf = lb_fwd_all[l].reshape(HG_HEADS, HG_EXPAND)
        lbb = lb_bwd_all[l].reshape(HG_HEADS, HG_EXPAND)
        logf_f, k_f = hgrn_gates(zf, lbf)
        logf_b, k_b = hgrn_gates(zb, lbb)
        logf_fc, k_fc = hgrn_gates(zf_c, lbf)
        logf_bc, k_bc = hgrn_gates(zb_c, lbb)
        o_fc, s_fc = hgrn2_chunk_scan(qh_c, k_fc, logf_fc, ih_c, s0)
        o_f, _ = hgrn2_chunk_scan(qh, k_f, logf_f, ih, s_fc)
        o_bc, s_bc = hgrn2_chunk_scan(flip(qh_c), flip(k_bc), flip(logf_bc), flip(ih_c), s0)
        o_b, _ = hgrn2_chunk_scan(flip(qh), flip(k_b), flip(logf_b), flip(ih), s_bc)
        o_hg = hg_output(o_f + flip(o_b), gh, hg_norm_w[l], h.dtype)

        h_new = finish_layer(h, jnp.concatenate([o_da, o_hg], axis=-1), gt1, sh2, sc2, gt2,
                             w_out[l], ln1_g[l], ln1_b[l], w_ff1[l], w_ff2[l], ln2_g[l], ln2_b[l])

        if l + 1 < DEPTH:
            o_da_c = da_output(diff_attend(qd_c, kd_c, vd_c, lam), da_norm_w[l], lam_init, hc.dtype)
            o_hg_c = hg_output(o_fc + flip(o_bc), gh_c, hg_norm_w[l], hc.dtype)
            hc = finish_layer(hc, jnp.concatenate([o_da_c, o_hg_c], axis=-1), cgt1, csh2, csc2, cgt2,
                              w_out[l], ln1_g[l], ln1_b[l], w_ff1[l], w_ff2[l], ln2_g[l], ln2_b[l])
        h = h_new
    return h
```

```cpp
#include <hip/hip_runtime.h>
#include <hip/hip_bf16.h>
#include <cstdio>
#include <cstdint>
#include <cmath>

constexpr int DM = 2048, NB = 8, SEQ = 2048, CTX = 256, NHEAD = 8, HD = 128;
constexpr int ML = NB * SEQ;
constexpr int MC = NB * CTX;
constexpr int MT = ML + MC;
constexpr int NIN = 8192, GW = 1024, DFF = 8192, NADA = 6 * DM;
constexpr float LN_EPS = 1e-5f;
constexpr float ALPHA_RES = 1.189207115002721f;
constexpr float ONE_M_LAMINIT = 0.8f;
constexpr float LAM_INIT = 0.2f;
constexpr size_t GSTRIDE = (size_t)MT * GW;
enum { G_QD = 0, G_KD = 1, G_VD = 2, G_QH = 3, G_ZF = 4, G_ZB = 5, G_IH = 6, G_GH = 7 };
typedef float f32x2g __attribute__((ext_vector_type(2)));
namespace pg8 {
#define PG8_LAS __attribute__((address_space(3)))
typedef unsigned short bf16_t;
typedef short bf16x8 __attribute__((ext_vector_type(8)));
typedef float f32x4 __attribute__((ext_vector_type(4)));
typedef unsigned u32x4 __attribute__((ext_vector_type(4)));
constexpr int BM = 256, BK = 64, HALF = 128, HTB = HALF * BK * 2  , STAGE_BYTES = 8 * HTB, NXCD = 8, WGM = 8;

__host__ __device__ __forceinline__ int lds_byte(int r, int c) { const int st = (r >> 4) * 2 + (c >> 5), rr = r & 15, cc = c & 31, ob = rr * 64 + cc * 2; return st * 1024 + (ob ^ (((ob >> 9) & 1) << 5)); }
__host__ __device__ __forceinline__ void stage_rc(int b, int& R, int& C) { const int st = b / 1024, sb = b % 1024, swz = sb ^ (((sb >> 9) & 1) << 5); R = (st >> 1) * 16 + swz / 64; C = (st & 1) * 32 + (swz % 64) / 2; }
__host__ __device__ __forceinline__ int perm32(int rho) { const int n = rho >> 4, i = rho & 15; return 8 * (i >> 2) + 4 * n + (i & 3); }

struct Unit { int pm, pn; };
struct Gemm { const bf16_t* A; const bf16_t* Bt; int M, N, K; };

struct StaticOrder {
    int nM, nN, nwg, G, c;
    __host__ __device__ void init(int M, int N, int G_, int c_) { nM = M / BM; nN = N / BM; nwg = nM * nN; G = G_; c = c_; }
    __host__ __device__ bool next(int i, Unit& u) const {
        const long L = (long)i * G + c; if (L >= nwg) return false;
        int wgid = (int)L; { const int q = nwg / NXCD, r = nwg % NXCD, xcd = wgid % NXCD, off = wgid / NXCD; wgid = (xcd < r ? xcd * (q + 1) : r * (q + 1) + (xcd - r) * q) + off; }
        const int nig = WGM * nN, gid = wgid / nig, fm = gid * WGM, gsz = (nM - fm) < WGM ? (nM - fm) : WGM;
        u.pm = fm + ((wgid % nig) % gsz); u.pn = (wgid % nig) / gsz; return true;
    }
    __device__ __forceinline__ void a_ready(const Unit&) const {}
    __device__ __forceinline__ void done(const Unit&) const {}
};

__device__ __forceinline__ unsigned cvt_pk_bf16(float lo, float hi) { unsigned r; asm volatile("v_cvt_pk_bf16_f32 %0, %1, %2" : "=v"(r) : "v"(lo), "v"(hi)); return r; }
__device__ __forceinline__ float sigmoid_f(float z) { return __builtin_amdgcn_rcpf(1.0f + __builtin_amdgcn_exp2f(-1.4426950408889634f * z)); }
__device__ __forceinline__ void store8_bf16(bf16_t* p, f32x4 v0, f32x4 v1) {
    u32x4 w; w.x = cvt_pk_bf16(v0[0], v0[1]); w.y = cvt_pk_bf16(v0[2], v0[3]); w.z = cvt_pk_bf16(v1[0], v1[1]); w.w = cvt_pk_bf16(v1[2], v1[3]); *(u32x4*)p = w; }

struct EpiInProj {
    static constexpr bool PERM = true, AFTER_DRAIN = false;
    bf16_t* P; const float* rope; const float* lbf; const float* lbb;
    __device__ __forceinline__ void operator()(const f32x4 (&acc)[2][2][4][2], const Unit& u, int wr, int wc, int fr, int fq) const {
        const int g = u.pn >> 2;
        bf16_t* base = P + (size_t)g * GSTRIDE;
        const int row0 = u.pm * BM + wr * 64 + fr;
        const int col0 = (u.pn & 3) * BM + wc * 32 + 8 * fq;
        if (g <= G_KD && u.pm < ML / BM) {
            const float sgn = (fq < 2) ? -1.f : 1.f;
#pragma unroll
            for (int ai = 0; ai < 2; ++ai)
#pragma unroll
                for (int m = 0; m < 4; ++m) {
                    const int row = row0 + ai * HALF + m * 16; const int t = row & (SEQ - 1);
                    const int pos = (wc & 1) ? (t & 63) : (t >> 6);
                    const f32x4* tp = (const f32x4*)(rope + (size_t)(pos * 16 + 8 * (fq & 1)) * 2);
                    const f32x4 t0 = tp[0], t1 = tp[1], t2 = tp[2], t3 = tp[3];
                    bf16_t* rowp = base + (size_t)row * GW + col0;
#pragma unroll
                    for (int bj = 0; bj < 2; ++bj) {
                        const f32x4 v0 = acc[ai][bj][m][0], v1 = acc[ai][bj][m][1];
                        f32x4 p0, p1;
#pragma unroll
                        for (int j = 0; j < 4; ++j) { p0[j] = sgn * __shfl_xor(v0[j], 32); p1[j] = sgn * __shfl_xor(v1[j], 32); }
                        f32x4 o0, o1;
                        o0[0] = v0[0] * t0[0] + p0[0] * t0[1]; o0[1] = v0[1] * t0[2] + p0[1] * t0[3];
                        o0[2] = v0[2] * t1[0] + p0[2] * t1[1]; o0[3] = v0[3] * t1[2] + p0[3] * t1[3];
                        o1[0] = v1[0] * t2[0] + p1[0] * t2[1]; o1[1] = v1[1] * t2[2] + p1[1] * t2[3];
                        o1[2] = v1[2] * t3[0] + p1[2] * t3[1]; o1[3] = v1[3] * t3[2] + p1[3] * t3[3];
                        store8_bf16(rowp + bj * HALF, o0, o1);
                    }
                }
        } else if (g == G_QH || g == G_GH) {
#pragma unroll
            for (int ai = 0; ai < 2; ++ai)
#pragma unroll
                for (int m = 0; m < 4; ++m) { bf16_t* rowp = base + (size_t)(row0 + ai * HALF + m * 16) * GW + col0;
#pragma unroll
                    for (int bj = 0; bj < 2; ++bj) { f32x4 v0 = acc[ai][bj][m][0], v1 = acc[ai][bj][m][1];
#pragma unroll
                        for (int j = 0; j < 4; ++j) { v0[j] = v0[j] * sigmoid_f(v0[j]); v1[j] = v1[j] * sigmoid_f(v1[j]); }
                        store8_bf16(rowp + bj * HALF, v0, v1); } }
        } else if (g == G_ZF || g == G_ZB) {
            const float* lbv = (g == G_ZF ? lbf : lbb) + col0;
            f32x4 lb[2][2];
#pragma unroll
            for (int bj = 0; bj < 2; ++bj) { lb[bj][0] = *(const f32x4*)(lbv + bj * HALF); lb[bj][1] = *(const f32x4*)(lbv + bj * HALF + 4); }
#pragma unroll
            for (int ai = 0; ai < 2; ++ai)
#pragma unroll
                for (int m = 0; m < 4; ++m) { bf16_t* rowp = base + (size_t)(row0 + ai * HALF + m * 16) * GW + col0;
#pragma unroll
                    for (int bj = 0; bj < 2; ++bj) { f32x4 v0 = acc[ai][bj][m][0], v1 = acc[ai][bj][m][1];
#pragma unroll
                        for (int j = 0; j < 4; ++j) {
                            const float l0 = lb[bj][0][j], l1 = lb[bj][1][j];
                            v0[j] = 0.6931471805599453f * __builtin_amdgcn_logf(l0 + (1.f - l0) * sigmoid_f(v0[j]));
                            v1[j] = 0.6931471805599453f * __builtin_amdgcn_logf(l1 + (1.f - l1) * sigmoid_f(v1[j])); }
                        store8_bf16(rowp + bj * HALF, v0, v1); } }
        } else {
#pragma unroll
            for (int ai = 0; ai < 2; ++ai)
#pragma unroll
                for (int m = 0; m < 4; ++m) { bf16_t* rowp = base + (size_t)(row0 + ai * HALF + m * 16) * GW + col0;
#pragma unroll
                    for (int bj = 0; bj < 2; ++bj) store8_bf16(rowp + bj * HALF, acc[ai][bj][m][0], acc[ai][bj][m][1]); }
        }
    }
};
struct EpiResid {
    static constexpr bool PERM = false, AFTER_DRAIN = false;
    const float* base; float* out; const float* gate;
    __device__ __forceinline__ void operator()(const f32x4 (&acc)[2][2][4][2], const Unit& u, int wr, int wc, int fr, int fq) const {
        const int row0 = u.pm * BM + wr * 64 + fr, col0 = u.pn * BM + wc * 32 + 4 * fq;
        const float* gp = gate + (size_t)(u.pm >> 3) * NADA + col0;
        f32x4 gv[2][2];
#pragma unroll
        for (int bj = 0; bj < 2; ++bj)
#pragma unroll
            for (int n = 0; n < 2; ++n) gv[bj][n] = *(const f32x4*)(gp + bj * HALF + n * 16);
#pragma unroll
        for (int ai = 0; ai < 2; ++ai)
#pragma unroll
            for (int m = 0; m < 4; ++m) { const size_t off = (size_t)(row0 + ai * HALF + m * 16) * DM + col0;
#pragma unroll
                for (int bj = 0; bj < 2; ++bj)
#pragma unroll
                    for (int n = 0; n < 2; ++n) { const f32x4 bs = *(const f32x4*)(base + off + bj * HALF + n * 16);
                        *(f32x4*)(out + off + bj * HALF + n * 16) = bs * ALPHA_RES + gv[bj][n] * acc[ai][bj][m][n]; } }
    }
};
struct EpiRelu2 {
    static constexpr bool PERM = true, AFTER_DRAIN = false;
    bf16_t* O; int ldc;
    __device__ __forceinline__ void operator()(const f32x4 (&acc)[2][2][4][2], const Unit& u, int wr, int wc, int fr, int fq) const {
        const int row0 = u.pm * BM + wr * 64 + fr, col0 = u.pn * BM + wc * 32 + 8 * fq;
#pragma unroll
        for (int ai = 0; ai < 2; ++ai)
#pragma unroll
            for (int m = 0; m < 4; ++m) { bf16_t* rowp = O + (size_t)(row0 + ai * HALF + m * 16) * ldc + col0;
#pragma unroll
                for (int bj = 0; bj < 2; ++bj) { f32x4 v0 = acc[ai][bj][m][0], v1 = acc[ai][bj][m][1];
#pragma unroll
                    for (int j = 0; j < 4; ++j) { const float a = fmaxf(v0[j], 0.f), b = fmaxf(v1[j], 0.f); v0[j] = a * a; v1[j] = b * b; }
                    store8_bf16(rowp + bj * HALF, v0, v1); } }
    }
};

template <class Epi, class Sched, bool ALIGN_EPI = false, bool SP2 = false>
__device__ __forceinline__ void gemm_phase(PG8_LAS unsigned char* lds, const Gemm g, const Sched& S, const Epi& E) {
    int tid_ = threadIdx.x; asm volatile("" : "+v"(tid_));
    const int tid = tid_, wid = __builtin_amdgcn_readfirstlane(tid >> 6), lane = tid & 63, wr = wid >> 2, wc = wid & 3, fr = lane & 15, fq = lane >> 4;
    const int K = g.K, nt = K / BK;
    unsigned voffA[2], voffB[2];
#pragma unroll
    for (int i = 0; i < 2; ++i) { int R, C; stage_rc(tid * 16 + i * 8192, R, C); const int Rb = Epi::PERM ? ((R & ~31) + perm32(R & 31)) : R;
        voffA[i] = (unsigned)(R * K + C) * 2u; voffB[i] = (unsigned)(Rb * K + C) * 2u; }
    const size_t kstep = (size_t)(BK * 2);
    const size_t hstep = (size_t)HALF * K * 2;
    const size_t tstep = 2 * hstep;
    const unsigned ldsw = (unsigned)wid * 1024u;
    const int aoff = lds_byte(wr * 64 + fr, fq * 8), boff = lds_byte(wc * 32 + fr, fq * 8);
#define PG8_SA(b, h) (((b) * 2 + (h)) * HTB)
#define PG8_SB(b, h) ((4 + (b) * 2 + (h)) * HTB)
#define PG8_STAGE(bufoff, gbase, voff) do { _Pragma("unroll") for (int _i = 0; _i < 2; ++_i) \
        __builtin_amdgcn_global_load_lds((const unsigned*)((const char*)(gbase) + (voff)[_i]), (PG8_LAS unsigned*)(lds + (bufoff) + ldsw + _i * 8192), 16, 0, 0); } while (0)
#define PG8_LDA(dst, b, h) do { _Pragma("unroll") for (int m = 0; m < 4; ++m) _Pragma("unroll") for (int k = 0; k < 2; ++k) dst[m][k] = *(const PG8_LAS bf16x8*)(lds + PG8_SA(b, h) + aoff + m * 2048 + k * 1024); } while (0)
#define PG8_LDB(dst, b, h) do { _Pragma("unroll") for (int n = 0; n < 2; ++n) _Pragma("unroll") for (int k = 0; k < 2; ++k) dst[n][k] = *(const PG8_LAS bf16x8*)(lds + PG8_SB(b, h) + boff + n * 2048 + k * 1024); } while (0)
#define PG8_MMA(ai, bj, At, Bt) do { __builtin_amdgcn_s_setprio(1); _Pragma("unroll") for (int m = 0; m < 4; ++m) _Pragma("unroll") for (int n = 0; n < 2; ++n) _Pragma("unroll") for (int k = 0; k < 2; ++k) \
        acc[ai][bj][m][n] = __builtin_amdgcn_mfma_f32_16x16x32_bf16(Bt[n][k], At[m][k], acc[ai][bj][m][n], 0, 0, 0); __builtin_amdgcn_s_setprio(0); } while (0)
#define PG8_WAIT_V(n) asm volatile("s_waitcnt vmcnt(" #n ")" ::: "memory")
#define PG8_WAIT_L(n) asm volatile("s_waitcnt lgkmcnt(" #n ")" ::: "memory")
#define PG8_BAR __builtin_amdgcn_s_barrier()
#define PG8_SCHED __builtin_amdgcn_sched_barrier(0)
    Unit cur, nxt; int ui = 0;
    if (!S.next(0, cur)) return;
    f32x4 acc[2][2][4][2];
#pragma unroll
    for (int a = 0; a < 2; ++a)
#pragma unroll
        for (int b = 0; b < 2; ++b)
#pragma unroll
            for (int m = 0; m < 4; ++m)
#pragma unroll
                for (int n = 0; n < 2; ++n) acc[a][b][m][n] = (f32x4){0.f, 0.f, 0.f, 0.f};
    bf16x8 At[4][2], B0[2][2], B1[2][2];
    const char* cA = (const char*)g.A + (size_t)cur.pm * tstep; const char* cB = (const char*)g.Bt + (size_t)cur.pn * tstep;
    S.a_ready(cur);
    if constexpr (SP2) {
        PG8_STAGE(PG8_SB(0, 0), cB, voffB); PG8_STAGE(PG8_SB(0, 1), cB + hstep, voffB); PG8_STAGE(PG8_SA(0, 0), cA, voffA); PG8_STAGE(PG8_SA(0, 1), cA + hstep, voffA);
        if (wr == 1) PG8_BAR;
        PG8_WAIT_V(2); PG8_BAR;
        PG8_STAGE(PG8_SB(1, 0), cB + kstep, voffB); PG8_STAGE(PG8_SA(1, 0), cA + kstep, voffA); PG8_STAGE(PG8_SB(1, 1), cB + hstep + kstep, voffB);
        PG8_WAIT_V(6); PG8_BAR;
    } else {
        PG8_STAGE(PG8_SB(0, 0), cB, voffB); PG8_STAGE(PG8_SA(0, 0), cA, voffA); PG8_STAGE(PG8_SB(0, 1), cB + hstep, voffB); PG8_STAGE(PG8_SA(0, 1), cA + hstep, voffA);
        if (wr == 1) PG8_BAR;
        PG8_WAIT_V(4); PG8_BAR;
        PG8_STAGE(PG8_SB(1, 0), cB + kstep, voffB); PG8_STAGE(PG8_SA(1, 0), cA + kstep, voffA); PG8_STAGE(PG8_SB(1, 1), cB + hstep + kstep, voffB);
        PG8_WAIT_V(6); PG8_BAR;
    }
    for (;;) {
        const bool has_next = S.next(ui + 1, nxt);
        const char* nA = has_next ? (const char*)g.A + (size_t)nxt.pm * tstep : cA; const char* nB = has_next ? (const char*)g.Bt + (size_t)nxt.pn * tstep : cB;
        for (int t = 0; t < nt; t += 2) {
            const bool last = (t == nt - 2);
            const char* a1 = cA + (size_t)(t + 1) * kstep;
            const char* a2 = last ? nA : cA + (size_t)(t + 2) * kstep; const char* b2 = last ? nB : cB + (size_t)(t + 2) * kstep;
            const char* a3 = a2 + kstep; const char* b3 = b2 + kstep;
            if (last && has_next) S.a_ready(nxt);
            if constexpr (SP2) {
            PG8_LDB(B0, 0, 0); PG8_LDB(B1, 0, 1); PG8_SCHED; PG8_LDA(At, 0, 0); PG8_STAGE(PG8_SA(1, 1), a1 + hstep, voffA);
            PG8_WAIT_V(8); PG8_WAIT_L(0); PG8_BAR; PG8_MMA(0, 0, At, B0); PG8_MMA(0, 1, At, B1); PG8_BAR; PG8_SCHED;
            PG8_LDA(At, 0, 1); PG8_STAGE(PG8_SB(0, 0), b2, voffB); PG8_STAGE(PG8_SB(0, 1), b2 + hstep, voffB); PG8_STAGE(PG8_SA(0, 0), a2, voffA);
            PG8_WAIT_V(8); PG8_WAIT_L(0); PG8_BAR; PG8_MMA(1, 0, At, B0); PG8_MMA(1, 1, At, B1); PG8_BAR; PG8_SCHED;
            PG8_LDB(B0, 1, 0); PG8_LDB(B1, 1, 1); PG8_SCHED; PG8_LDA(At, 1, 0); PG8_STAGE(PG8_SA(0, 1), a2 + hstep, voffA);
            PG8_WAIT_V(8); PG8_WAIT_L(0); PG8_BAR; PG8_MMA(0, 0, At, B0); PG8_MMA(0, 1, At, B1); PG8_BAR; PG8_SCHED;
            PG8_LDA(At, 1, 1); PG8_STAGE(PG8_SB(1, 0), b3, voffB); PG8_STAGE(PG8_SB(1, 1), b3 + hstep, voffB); PG8_STAGE(PG8_SA(1, 0), a3, voffA);
            PG8_WAIT_V(8); PG8_WAIT_L(0); PG8_BAR; PG8_MMA(1, 0, At, B0); PG8_MMA(1, 1, At, B1); PG8_BAR; PG8_SCHED;
            } else {
            PG8_LDB(B0, 0, 0); PG8_SCHED; PG8_LDA(At, 0, 0); PG8_STAGE(PG8_SA(1, 1), a1 + hstep, voffA);
            PG8_WAIT_L(8); PG8_BAR; PG8_WAIT_L(0); PG8_MMA(0, 0, At, B0); PG8_BAR; PG8_SCHED;
            PG8_LDB(B1, 0, 1); PG8_STAGE(PG8_SB(0, 0), b2, voffB);
            PG8_BAR; PG8_WAIT_L(0); PG8_MMA(0, 1, At, B1); PG8_BAR;
            PG8_LDA(At, 0, 1); PG8_STAGE(PG8_SA(0, 0), a2, voffA);
            PG8_BAR; PG8_WAIT_L(0); PG8_MMA(1, 0, At, B0); PG8_BAR; PG8_SCHED;
            PG8_STAGE(PG8_SB(0, 1), b2 + hstep, voffB);
            PG8_WAIT_V(6); PG8_BAR; PG8_MMA(1, 1, At, B1); PG8_BAR;
            PG8_LDB(B0, 1, 0); PG8_SCHED; PG8_LDA(At, 1, 0); PG8_STAGE(PG8_SA(0, 1), a2 + hstep, voffA);
            PG8_WAIT_L(8); PG8_BAR; PG8_WAIT_L(0); PG8_MMA(0, 0, At, B0); PG8_BAR; PG8_SCHED;
            PG8_LDB(B1, 1, 1); PG8_STAGE(PG8_SB(1, 0), b3, voffB);
            PG8_BAR; PG8_WAIT_L(0); PG8_MMA(0, 1, At, B1); PG8_BAR;
            PG8_LDA(At, 1, 1); PG8_STAGE(PG8_SA(1, 0), a3, voffA);
            PG8_BAR; PG8_WAIT_L(0); PG8_MMA(1, 0, At, B0); PG8_BAR; PG8_SCHED;
            PG8_STAGE(PG8_SB(1, 1), b3 + hstep, voffB);
            PG8_WAIT_V(6); PG8_BAR; PG8_MMA(1, 1, At, B1); PG8_BAR;
            }
        }
        if constexpr (ALIGN_EPI) { if (wr == 0) PG8_BAR; }
        if constexpr (!Epi::AFTER_DRAIN) { E(acc, cur, wr, wc, fr, fq); S.done(cur); }
        if (!has_next) break;
#pragma unroll
        for (int a = 0; a < 2; ++a)
#pragma unroll
            for (int b = 0; b < 2; ++b)
#pragma unroll
                for (int m = 0; m < 4; ++m)
#pragma unroll
                    for (int n = 0; n < 2; ++n) acc[a][b][m][n] = (f32x4){0.f, 0.f, 0.f, 0.f};
        cur = nxt; cA = nA; cB = nB; ++ui;
        if constexpr (ALIGN_EPI) { if (wr == 1) PG8_BAR; }
    }
    PG8_WAIT_V(0);
    if constexpr (!ALIGN_EPI) { if (wr == 0) PG8_BAR; }
    PG8_BAR;
    if constexpr (Epi::AFTER_DRAIN) { E.fused(acc, cur, wr, wc, fr, fq, lds, wid, lane); S.done(cur); }
#undef PG8_SA
#undef PG8_SB
#undef PG8_STAGE
#undef PG8_LDA
#undef PG8_LDB
#undef PG8_MMA
#undef PG8_WAIT_V
#undef PG8_WAIT_L
#undef PG8_BAR
#undef PG8_SCHED
}
}

namespace da {
using bf16 = unsigned short;
using bf16x8 = __attribute__((ext_vector_type(8))) short;
using s16x4  = __attribute__((ext_vector_type(4))) short;
using f32x16 = __attribute__((ext_vector_type(16))) float;
using f32x4  = __attribute__((ext_vector_type(4))) float;
using u32x4  = __attribute__((ext_vector_type(4))) unsigned;
constexpr float SCALE = 0.125f;
constexpr float THR = 8.f;
constexpr int KVBLK = 64, NT = (SEQ + CTX) / KVBLK;
constexpr int SHM_V = 16384, SHM_K = 16384, LDS_VOFF = 0, LDS_KOFF = 32768, LDS_WSOFF = 69632, XSTRIDE = 132;
#define KSWZ(row, colB) ((row) * 256 + ((colB) ^ (((row) & 7) << 4)))
#define SBAR() __builtin_amdgcn_sched_barrier(0)
__device__ __forceinline__ int crow(int r, int hi) { return (r & 3) + 8 * (r >> 2) + 4 * hi; }
__device__ __forceinline__ unsigned cvtpk(float lo, float hi) { unsigned r; asm volatile("v_cvt_pk_bf16_f32 %0, %1, %2" : "=v"(r) : "v"(lo), "v"(hi)); return r; }
__device__ __forceinline__ void partialSM(f32x16& p0, f32x16& p1, float& m_reg, float& mn, float& alpha) {
  constexpr float C = SCALE * 1.4426950408889634f;
  float pmax = p0[0];
#pragma unroll
  for (int r = 1; r < 16; ++r) pmax = fmaxf(pmax, p0[r]);
#pragma unroll
  for (int r = 0; r < 16; ++r) pmax = fmaxf(pmax, p1[r]);
  { auto rr = __builtin_amdgcn_permlane32_swap(__float_as_uint(pmax), __float_as_uint(pmax), false, false);
    pmax = fmaxf(__uint_as_float(rr[0]), __uint_as_float(rr[1])); }
  if (__builtin_expect(__all(pmax - m_reg <= THR / SCALE), 1)) { mn = m_reg; alpha = 1.f; }
  else { mn = fmaxf(m_reg, pmax); alpha = __builtin_amdgcn_exp2f((m_reg - mn) * C); m_reg = mn; }
  float mnC = -mn * C;
#pragma unroll
  for (int r = 0; r < 16; ++r) p0[r] = fmaf(p0[r], C, mnC);
#pragma unroll
  for (int r = 0; r < 16; ++r) p1[r] = fmaf(p1[r], C, mnC);
#pragma unroll
  for (int r = 0; r < 16; ++r) p0[r] = __builtin_amdgcn_exp2f(p0[r]);
}
__device__ __forceinline__ void finishSM(f32x16& p0, f32x16& p1, float alpha, float& l_reg, bf16x8& pa0, bf16x8& pa1, bf16x8& pa2, bf16x8& pa3) {
#pragma unroll
  for (int r = 0; r < 16; ++r) p1[r] = __builtin_amdgcn_exp2f(p1[r]);
  float ps = 0;
#pragma unroll
  for (int r = 0; r < 16; ++r) ps += p0[r];
#pragma unroll
  for (int r = 0; r < 16; ++r) ps += p1[r];
  { auto rr = __builtin_amdgcn_permlane32_swap(__float_as_uint(ps), __float_as_uint(ps), false, false);
    ps = __uint_as_float(rr[0]) + __uint_as_float(rr[1]); }
  l_reg = l_reg * alpha + ps;
#define PK4(P, BASE, OUT) do { unsigned a0 = cvtpk(P[BASE + 0], P[BASE + 1]), a1 = cvtpk(P[BASE + 2], P[BASE + 3]);   \
    unsigned b0 = cvtpk(P[BASE + 4], P[BASE + 5]), b1 = cvtpk(P[BASE + 6], P[BASE + 7]);                              \
    auto r0 = __builtin_amdgcn_permlane32_swap(a0, b0, false, false); auto r1 = __builtin_amdgcn_permlane32_swap(a1, b1, false, false); \
    u32x4 w = {r0[0], r1[0], r0[1], r1[1]}; OUT = *reinterpret_cast<bf16x8*>(&w); } while (0)
  PK4(p0, 0, pa0); PK4(p0, 8, pa1); PK4(p1, 0, pa2); PK4(p1, 8, pa3);
#undef PK4
}
__device__ __forceinline__ void qkt(f32x16& p0, f32x16& p1, const bf16* Ks, const bf16x8* qr, int r32, int hi, int cb0) {
  p0 = f32x16{}; p1 = f32x16{};
#pragma unroll
  for (int d0 = 0; d0 < 4; ++d0) { int cb = (cb0 + d0 * 16 + hi * 8) * 2;
    bf16x8 b0 = *reinterpret_cast<const bf16x8*>((const char*)Ks + KSWZ(r32, cb));
    bf16x8 b1 = *reinterpret_cast<const bf16x8*>((const char*)Ks + KSWZ(32 + r32, cb));
    p0 = __builtin_amdgcn_mfma_f32_32x32x16_bf16(b0, qr[d0], p0, 0, 0, 0);
    p1 = __builtin_amdgcn_mfma_f32_32x32x16_bf16(b1, qr[d0], p1, 0, 0, 0); }
}
__device__ __forceinline__ int v_st(int k, int c) { const int kk = (k & ~0xC) | ((k & 4) << 1) | ((k & 8) >> 1); return ((kk >> 3) * 4 + (c >> 5)) * 512 + ((kk & 7) * 32 + (c & 31)) * 2; }
__device__ __forceinline__ int v_rd_base(int lane) { return ((lane & 3) << 3) | (((lane >> 2) & 3) << 6) | (((lane >> 4) & 1) << 5) | (((lane >> 5) & 1) << 8); }
constexpr int v_rd_off(int d0, int ks, int half) { return d0 * 512 + ks * 4096 + half * 2048; }
template <int OFF> __device__ __forceinline__ s16x4 tr_read(int vb) {
  s16x4 r; asm volatile("ds_read_b64_tr_b16 %0, %1 offset:%2" : "=&v"(r) : "v"(vb), "i"(OFF) : "memory"); return r;
}
template <int D0> __device__ __forceinline__ void pv_one(f32x16& od, int vb, bf16x8 pa0, bf16x8 pa1, bf16x8 pa2, bf16x8 pa3) {
  const s16x4 l0 = tr_read<v_rd_off(D0, 0, 0)>(vb), h0 = tr_read<v_rd_off(D0, 0, 1)>(vb), l1 = tr_read<v_rd_off(D0, 1, 0)>(vb), h1 = tr_read<v_rd_off(D0, 1, 1)>(vb);
  const s16x4 l2 = tr_read<v_rd_off(D0, 2, 0)>(vb), h2 = tr_read<v_rd_off(D0, 2, 1)>(vb), l3 = tr_read<v_rd_off(D0, 3, 0)>(vb), h3 = tr_read<v_rd_off(D0, 3, 1)>(vb);
  asm volatile("s_waitcnt lgkmcnt(0)" ::: "memory"); SBAR();
#define PK(L, H) (bf16x8){L[0], L[1], L[2], L[3], H[0], H[1], H[2], H[3]}
  od = __builtin_amdgcn_mfma_f32_32x32x16_bf16(pa0, PK(l0, h0), od, 0, 0, 0);
  od = __builtin_amdgcn_mfma_f32_32x32x16_bf16(pa1, PK(l1, h1), od, 0, 0, 0);
  od = __builtin_amdgcn_mfma_f32_32x32x16_bf16(pa2, PK(l2, h2), od, 0, 0, 0);
  od = __builtin_amdgcn_mfma_f32_32x32x16_bf16(pa3, PK(l3, h3), od, 0, 0, 0);
#undef PK
}
__device__ __forceinline__ void pv_d0(f32x16* o, int vb, bf16x8 pa0, bf16x8 pa1, bf16x8 pa2, bf16x8 pa3) {
  pv_one<0>(o[0], vb, pa0, pa1, pa2, pa3); pv_one<1>(o[1], vb, pa0, pa1, pa2, pa3); pv_one<2>(o[2], vb, pa0, pa1, pa2, pa3); pv_one<3>(o[3], vb, pa0, pa1, pa2, pa3);
}
__device__ __forceinline__ size_t tile_row(int b, int j) { return (j < SEQ / KVBLK) ? (size_t)b * SEQ + (size_t)j * KVBLK : (size_t)ML + (size_t)b * CTX + (size_t)(j - SEQ / KVBLK) * KVBLK; }

__device__ __forceinline__ void attn_unit(char* lds, const bf16* __restrict__ QD, const bf16* __restrict__ KD, const bf16* __restrict__ VD, bf16* __restrict__ MIXED,
                                          const float* __restrict__ da_w, int b, int h, int qb, float lam) {
  int tid_ = threadIdx.x; asm volatile("" : "+v"(tid_));
  const int tid = tid_, wid = __builtin_amdgcn_readfirstlane(tid >> 6), lane = tid & 63, r32 = lane & 31, hi = lane >> 5;
  const int mp = wid >> 2, wq = wid & 3;
  bf16* V_lds = (bf16*)(lds + LDS_VOFF); bf16* K_lds = (bf16*)(lds + LDS_KOFF);
  float* ws = (float*)(lds + LDS_WSOFF) + wid * 64; float* li_l = ws; float* al_l = ws + 32;
  float m_reg = -1e30f, l_reg = 0; f32x16 o[4] = {}; bf16x8 qr[4];
  const bf16* Qw = QD + ((size_t)b * SEQ + qb * 128 + wq * 32 + r32) * GW + h * HD + mp * 64 + hi * 8;
#pragma unroll
  for (int d0 = 0; d0 < 4; ++d0) qr[d0] = *reinterpret_cast<const bf16x8*>(Qw + d0 * 16);
  const bf16* Kh = KD + h * HD; const bf16* Vh = VD + h * HD;
  const int sr = tid >> 4, sc = (tid & 15) * 8, vst0 = v_st(sr, sc), vst1 = v_st(32 + sr, sc);
  const int vb0 = (int)(uintptr_t)V_lds + v_rd_base(lane);
  const int cb0 = mp * 64;
  struct { bf16x8 vs0, vs1, ks0, ks1; } sr_[2];
#define SLOAD(i, j) do { const size_t kr_ = tile_row(b, (j)); \
    sr_[i].vs0 = *reinterpret_cast<const bf16x8*>(&Vh[(kr_ + sr) * GW + sc]); sr_[i].vs1 = *reinterpret_cast<const bf16x8*>(&Vh[(kr_ + 32 + sr) * GW + sc]); \
    sr_[i].ks0 = *reinterpret_cast<const bf16x8*>(&Kh[(kr_ + sr) * GW + sc]); sr_[i].ks1 = *reinterpret_cast<const bf16x8*>(&Kh[(kr_ + 32 + sr) * GW + sc]); } while (0)
#define SWRITE(bb, i) do { *(bf16x8*)((char*)V_lds + (bb) * SHM_V + vst0) = sr_[i].vs0;          \
    *(bf16x8*)((char*)V_lds + (bb) * SHM_V + vst1) = sr_[i].vs1; int kc = sc * 2;               \
    *(bf16x8*)((char*)K_lds + (bb) * SHM_K + KSWZ(sr, kc)) = sr_[i].ks0;                       \
    *(bf16x8*)((char*)K_lds + (bb) * SHM_K + KSWZ(32 + sr, kc)) = sr_[i].ks1; } while (0)
#define SWAIT() asm volatile("s_waitcnt vmcnt(4)" ::: "memory")
#define RESC(a) do { if (__any((a) < 1.f)) { if (hi == 0) al_l[r32] = (a); asm volatile("s_waitcnt lgkmcnt(0)" ::: "memory"); \
    _Pragma("unroll") for (int d = 0; d < 4; ++d) _Pragma("unroll") for (int r = 0; r < 16; ++r) o[d][r] *= al_l[crow(r, hi)]; } } while (0)
  f32x16 pA0, pA1, pB0, pB1; float mnA, mnB, alA, alB; bf16x8 pa0, pa1, pa2, pa3;
  constexpr int SE = 0, SO = 1;
  SLOAD(SE, 0); asm volatile("s_waitcnt vmcnt(0)" ::: "memory"); SWRITE(0, SE); __syncthreads();
  qkt(pA0, pA1, K_lds, qr, r32, hi, cb0); partialSM(pA0, pA1, m_reg, mnA, alA);
  SLOAD(SO, 1); SLOAD(SE, 2);
  SWAIT(); SWRITE(1, SO); __syncthreads();
  for (int j = 1; j + 1 < NT; j += 2) {
    SBAR(); qkt(pB0, pB1, (bf16*)((char*)K_lds + SHM_K), qr, r32, hi, cb0);
    finishSM(pA0, pA1, alA, l_reg, pa0, pa1, pa2, pa3); SBAR();
    SLOAD(SO, j + 2); SBAR();
    pv_d0(o, vb0, pa0, pa1, pa2, pa3); partialSM(pB0, pB1, m_reg, mnB, alB);
    __syncthreads(); SWAIT(); SWRITE(0, SE);
    RESC(alB); __syncthreads();
    SBAR(); qkt(pA0, pA1, K_lds, qr, r32, hi, cb0);
    finishSM(pB0, pB1, alB, l_reg, pa0, pa1, pa2, pa3); SBAR();
    if (j + 3 < NT) SLOAD(SE, j + 3); SBAR();
    pv_d0(o, vb0 + SHM_V, pa0, pa1, pa2, pa3); partialSM(pA0, pA1, m_reg, mnA, alA);
    __syncthreads(); SWAIT(); SWRITE(1, SO);
    RESC(alA); __syncthreads();
  }
  SBAR(); qkt(pB0, pB1, (bf16*)((char*)K_lds + SHM_K), qr, r32, hi, cb0);
  finishSM(pA0, pA1, alA, l_reg, pa0, pa1, pa2, pa3); SBAR();
  pv_d0(o, vb0, pa0, pa1, pa2, pa3); partialSM(pB0, pB1, m_reg, mnB, alB);
  __syncthreads(); RESC(alB);
  finishSM(pB0, pB1, alB, l_reg, pa0, pa1, pa2, pa3); SBAR();
  pv_d0(o, vb0 + SHM_V, pa0, pa1, pa2, pa3);
  if (hi == 0) li_l[r32] = l_reg; asm volatile("s_waitcnt lgkmcnt(0)" ::: "memory");
  float rli[16];
  const float fac = mp ? lam : 1.f;
#pragma unroll
  for (int r = 0; r < 16; ++r) rli[r] = __builtin_amdgcn_rcpf(li_l[crow(r, hi)]) * fac;
  __syncthreads();
  float* X = (float*)lds;
  if (mp == 1) {
#pragma unroll
    for (int r = 0; r < 16; ++r)
#pragma unroll
      for (int d0 = 0; d0 < 4; ++d0) X[(wq * 32 + crow(r, hi)) * XSTRIDE + d0 * 32 + r32] = o[d0][r] * rli[r];
  }
  __syncthreads();
  if (mp == 0) {
#pragma unroll
    for (int r = 0; r < 16; ++r)
#pragma unroll
      for (int d0 = 0; d0 < 4; ++d0) { float* p = &X[(wq * 32 + crow(r, hi)) * XSTRIDE + d0 * 32 + r32]; *p = o[d0][r] * rli[r] - *p; }
  }
  __syncthreads();
  { const int row = tid >> 2, q4 = tid & 3;
    const float* xr = X + row * XSTRIDE + q4 * 32;
    f32x4 v[8]; float ss = 0.f;
#pragma unroll
    for (int i = 0; i < 8; ++i) { v[i] = *(const f32x4*)(xr + 4 * i); ss += (v[i][0] * v[i][0] + v[i][1] * v[i][1]) + (v[i][2] * v[i][2] + v[i][3] * v[i][3]); }
    ss += __shfl_xor(ss, 1); ss += __shfl_xor(ss, 2);
    const float rs = ONE_M_LAMINIT / sqrtf(ss * (1.f / 128.f) + LN_EPS);
    bf16* op = MIXED + ((size_t)b * SEQ + qb * 128 + row) * DM + h * HD + q4 * 32;
#pragma unroll
    for (int i = 0; i < 4; ++i) { const f32x4 w0 = *(const f32x4*)(da_w + q4 * 32 + 8 * i), w1 = *(const f32x4*)(da_w + q4 * 32 + 8 * i + 4);
      const f32x4 a = v[2 * i] * w0 * rs, c = v[2 * i + 1] * w1 * rs;
      u32x4 w; w.x = cvtpk(a[0], a[1]); w.y = cvtpk(a[2], a[3]); w.z = cvtpk(c[0], c[1]); w.w = cvtpk(c[2], c[3]);
      *(u32x4*)(op + 8 * i) = w; } }
  __syncthreads();
#undef SLOAD
#undef SWRITE
#undef SWAIT
#undef RESC
}
#undef KSWZ
#undef SBAR
}

constexpr int NWAVES = 8;
constexpr size_t MiB = 1u << 20;
constexpr size_t WS_CTL = 0, CTL_ZERO_BYTES = 1 * MiB;
constexpr size_t WS_SMALL = 1 * MiB;
constexpr size_t SM_ADA = 0, SM_ROPE = 448 * 1024, SM_LBF = 464 * 1024, SM_LBB = 468 * 1024;
constexpr size_t WS_WOUT = 2 * MiB, WS_WFF1 = 10 * MiB, WS_WFF2 = 42 * MiB, WS_WIN = 74 * MiB;
constexpr size_t WS_XM = 106 * MiB;
constexpr size_t WS_P = 178 * MiB;
constexpr size_t WS_U = 178 * MiB, WS_H = 242 * MiB, WS_END = 498 * MiB;
static_assert(WS_P + 8 * GSTRIDE * 2 <= WS_END && WS_H + (size_t)ML * DFF * 2 <= WS_END && WS_U + (size_t)ML * DM * 2 <= WS_H && WS_XM + (size_t)MT * DM * 2 <= WS_P, "d_ws map");
static_assert(9 * NADA * 4 <= SM_ROPE && SM_ROPE + 64 * 16 * 8 <= SM_LBF, "small map");
constexpr int CW_TMO = 0, CW_CODE = 1, CW_BAR = 4096, CW_Q = 16384;

constexpr int LDS_BYTES = 147456;
constexpr int LDSCTL_OFF = LDS_BYTES - 512;

#define GAS __attribute__((address_space(1)))
#define LAS __attribute__((address_space(3)))
typedef unsigned short bf16;
typedef unsigned v4u __attribute__((ext_vector_type(4)));
typedef unsigned v2u __attribute__((ext_vector_type(2)));
typedef float f32x4 __attribute__((ext_vector_type(4)));
typedef GAS unsigned gu32;
#define RLX_AGENT __ATOMIC_RELAXED, __HIP_MEMORY_SCOPE_AGENT
#define LDS_WAIT() asm volatile("s_waitcnt lgkmcnt(0)" ::: "memory")
#define VM_WAIT() asm volatile("s_waitcnt vmcnt(0)" ::: "memory")
__device__ __forceinline__ unsigned f2bf(float f) { unsigned u = __builtin_bit_cast(unsigned, f); return (u + 0x7fffu + ((u >> 16) & 1u)) >> 16; }
__device__ __forceinline__ unsigned pk2(float lo, float hi) { return f2bf(lo) | (f2bf(hi) << 16); }
__device__ __forceinline__ float bf_lo(unsigned w) { return __uint_as_float(w << 16); }
__device__ __forceinline__ float bf_hi(unsigned w) { return __uint_as_float(w & 0xffff0000u); }

#define XB_TMO      128
#define XB_XCNT(j)  (256  + 64 * (j))
#define XB_XSUB(j)  (1280 + 64 * (j))
#define XB_XGEN(j)  (2304 + 64 * (j))
#define XB_TOP      3328
#define XB_TOPGEN   3392
#define XCD_BAR_WORDS 3456
#define XB_SPIN_CAP (1u << 18)

__device__ __forceinline__ unsigned xb_ld(unsigned* p)              { return __hip_atomic_load(p, __ATOMIC_RELAXED, __HIP_MEMORY_SCOPE_AGENT); }
__device__ __forceinline__ unsigned xb_add(unsigned* p, unsigned v) { return __hip_atomic_fetch_add(p, v, __ATOMIC_RELAXED, __HIP_MEMORY_SCOPE_AGENT); }
__device__ __forceinline__ unsigned xb_xcc_id() { return (unsigned)__builtin_amdgcn_s_getreg((3 << 11) | 20) & 0xFu; }
#define XB_SPIN(cond, bar) do { unsigned _sp = 0; while (cond) { __builtin_amdgcn_s_sleep(1); \
    if ((++_sp & 255u) == 0u) { if (xb_ld(&(bar)[XB_TMO])) break; if (_sp > XB_SPIN_CAP) { atomicAdd(&(bar)[XB_TMO], 1u); break; } } } } while (0)

struct XcdBarrier {
    unsigned* bar; unsigned x;
    volatile LAS unsigned* st;
};

__device__ __forceinline__ XcdBarrier xcd_barrier_post(unsigned* bar, volatile LAS unsigned* st) {
    XcdBarrier b; b.bar = bar; b.x = xb_xcc_id(); b.st = st;
    if (threadIdx.x == 0) (void)xb_add(&bar[XB_XCNT(b.x)], 1u);
    return b;
}
__device__ __forceinline__ void xcd_barrier_complete(unsigned* bar, unsigned x, unsigned& nloc, unsigned& nx) {
    const unsigned G = gridDim.x * gridDim.y * gridDim.z;
    unsigned sum, cnt, mine, sp = 0u;
    for (;;) {
        sum = 0u; cnt = 0u; mine = 0u;
#pragma unroll
        for (unsigned j = 0; j < 16; ++j) { const unsigned c = xb_ld(&bar[XB_XCNT(j)]); sum += c; cnt += (c > 0u) ? 1u : 0u; mine = (j == x) ? c : mine; }
        if (sum == G) break;
        __builtin_amdgcn_s_sleep(1);
        if ((++sp & 255u) == 0u) { if (xb_ld(&bar[XB_TMO])) break; if (sp > XB_SPIN_CAP) { atomicAdd(&bar[XB_TMO], 1u); break; } }
    }
    nloc = mine > 0u ? mine : 1u; nx = cnt > 0u ? cnt : 1u;
}

__device__ __forceinline__ void xcd_barrier(const XcdBarrier& b) {
    asm volatile("s_waitcnt vmcnt(0)" ::: "memory");
    __syncthreads();
    if (threadIdx.x == 0) {
        unsigned* bar = b.bar;
        __builtin_amdgcn_s_waitcnt(0);
        unsigned nloc = b.st[0], nx = b.st[1];
        if (nloc == 0u) { xcd_barrier_complete(bar, b.x, nloc, nx); b.st[0] = nloc; b.st[1] = nx; }
        const unsigned old = xb_add(&bar[XB_XSUB(b.x)], 1u);
        const unsigned gen = old / nloc;
        if (old + 1u == (gen + 1u) * nloc) {
            __builtin_amdgcn_fence(__ATOMIC_RELEASE, "agent");
            asm volatile("s_waitcnt vmcnt(0)" ::: "memory");
            const unsigned og = xb_add(&bar[XB_TOP], 1u);
            const unsigned tg = og / nx;
            if (og + 1u == (tg + 1u) * nx) xb_add(&bar[XB_TOPGEN], 1u);
            else XB_SPIN(xb_ld(&bar[XB_TOPGEN]) == tg, bar);
            __builtin_amdgcn_fence(__ATOMIC_ACQUIRE, "agent");
            xb_add(&bar[XB_XGEN(b.x)], 1u);
            asm volatile("s_waitcnt vmcnt(0)" ::: "memory");
        } else {
            XB_SPIN(xb_ld(&bar[XB_XGEN(b.x)]) == gen, bar);
            __builtin_amdgcn_fence(__ATOMIC_ACQUIRE, "agent");
            asm volatile("s_waitcnt vmcnt(0)" ::: "memory");
        }
    }
    __syncthreads();
}

struct Frame {
    LAS unsigned char* lds;
    volatile LAS unsigned* MISC;
    gu32* ctl;
    int vcu, G;
    const float* in[22];
    float* out;
    unsigned char* ws;
};
__device__ __forceinline__ int opaque_tid() { int t = threadIdx.x; asm volatile("" : "+v"(t)); return t; }
__device__ __forceinline__ float wave_sum(float v) {
#pragma unroll
    for (int o = 1; o < 64; o <<= 1) v += __shfl_xor(v, o);
    return v;
}
__device__ __forceinline__ void p0_transpose_item(const float* W, int K, int N, bf16* WT, LAS float* scr, int item, int lane) {
    const int nblk = N / 32, kb = item / nblk, nb = item % nblk, k0 = 64 * kb, n0 = 32 * nb;
#pragma unroll 8
    for (int i = 0; i < 32; ++i) { const int kk = 2 * i + (lane >> 5); scr[kk * 33 + (lane & 31)] = W[(size_t)(k0 + kk) * N + n0 + (lane & 31)]; }
    LDS_WAIT(); asm volatile("" ::: "memory");
    const int c = lane & 7;
#pragma unroll
    for (int j = 0; j < 4; ++j) { const int n = (lane >> 3) + 8 * j; const LAS float* s = scr + (8 * c) * 33 + n;
        v4u o; o.x = pk2(s[0 * 33], s[1 * 33]); o.y = pk2(s[2 * 33], s[3 * 33]); o.z = pk2(s[4 * 33], s[5 * 33]); o.w = pk2(s[6 * 33], s[7 * 33]);
        *(GAS v4u*)(WT + (size_t)(n0 + n) * K + k0 + 8 * c) = o; }
    LDS_WAIT(); asm volatile("" ::: "memory");
}

__device__ __forceinline__ void p0_prologue(Frame& F) {
    const int tid = opaque_tid(), lane = tid & 63, wave = __builtin_amdgcn_readfirstlane(tid >> 6); (void)lane; (void)wave;
    const float* c = F.in[1]; const float* c_ctx = F.in[3]; const float* w_ada = F.in[4]; const float* b_ada = F.in[5];
    float* M_ADA = (float*)(F.ws + WS_SMALL + SM_ADA);
    { const int gt = F.vcu * (NWAVES * 64) + tid;
      if (gt < 1024) { const int pos = gt >> 4, i = gt & 15;
          const float inv = __builtin_amdgcn_exp2f(-(float)i * (13.287712379549449f / 16.f));
          const float rev = (float)pos * inv * 0.15915494309189535f;
          float* rp = (float*)(F.ws + WS_SMALL + SM_ROPE) + 2 * gt; rp[0] = __builtin_amdgcn_cosf(rev); rp[1] = __builtin_amdgcn_sinf(rev); }
      else if (gt < 3072) { const int k = gt - 1024, which = k >> 10, ch = k & 1023; const float* src = which ? F.in[13] : F.in[12];
          const float a0 = src[ch], a1 = src[1024 + ch];
          ((float*)(F.ws + WS_SMALL + (which ? SM_LBB : SM_LBF)))[ch] = 1.f / (1.f + expf(a1 - a0)); } }
    LAS float* scond = (LAS float*)F.lds;
    for (int i = tid; i < 9 * DM; i += NWAVES * 64) { const int r = i >> 11, k = i & (DM - 1); const float cv = (r < 8) ? c[r * DM + k] : c_ctx[k]; scond[i] = cv / (1.f + expf(-cv)); }
    __syncthreads();
    LAS float* red = (LAS float*)(F.lds + 9 * DM * 4);
    for (int item = F.vcu; item < NADA / 32; item += F.G) {
        const int c0 = item * 32, kr = lane >> 3, cq = (lane & 7) * 4;
        float acc[9][4];
#pragma unroll
        for (int r = 0; r < 9; ++r) { acc[r][0] = 0.f; acc[r][1] = 0.f; acc[r][2] = 0.f; acc[r][3] = 0.f; }
#pragma unroll 4
        for (int it = 0; it < 32; ++it) {
            const int k = it * 64 + wave * 8 + kr;
            const f32x4 w = *(const GAS f32x4*)(w_ada + (size_t)k * NADA + c0 + cq);
#pragma unroll
            for (int r = 0; r < 9; ++r) { const float s = scond[r * DM + k]; acc[r][0] += s * w[0]; acc[r][1] += s * w[1]; acc[r][2] += s * w[2]; acc[r][3] += s * w[3]; }
        }
#pragma unroll
        for (int r = 0; r < 9; ++r)
#pragma unroll
            for (int j = 0; j < 4; ++j) { float v = acc[r][j]; v += __shfl_xor(v, 8); v += __shfl_xor(v, 16); v += __shfl_xor(v, 32); acc[r][j] = v; }
        if (lane < 8) {
#pragma unroll
            for (int r = 0; r < 9; ++r)
#pragma unroll
                for (int j = 0; j < 4; ++j) red[(wave * 9 + r) * 32 + cq + j] = acc[r][j]; }
        __syncthreads();
        if (tid < 288) { const int r = tid >> 5, cc = tid & 31; float s = 0.f;
#pragma unroll
            for (int w = 0; w < 8; ++w) s += red[(w * 9 + r) * 32 + cc];
            M_ADA[r * NADA + c0 + cc] = s + b_ada[c0 + cc]; }
        __syncthreads();
    }
    LAS float* scr = (LAS float*)(F.lds + wave * 8448);
    const int gw = F.vcu * NWAVES + wave, NGW = F.G * NWAVES;
    constexpr int I_IN = (DM / 64) * (NIN / 32), I_OUT = (DM / 64) * (DM / 32), I_F1 = (DM / 64) * (DFF / 32), I_F2 = (DFF / 64) * (DM / 32);
    constexpr int NITEMS = I_IN + I_OUT + I_F1 + I_F2;
    for (int it = gw; it < NITEMS; it += NGW) {
        int r = it;
        if (r < I_IN) { p0_transpose_item(F.in[6], DM, NIN, (bf16*)(F.ws + WS_WIN), scr, r, lane); continue; } r -= I_IN;
        if (r < I_OUT) { p0_transpose_item(F.in[15], DM, DM, (bf16*)(F.ws + WS_WOUT), scr, r, lane); continue; } r -= I_OUT;
        if (r < I_F1) { p0_transpose_item(F.in[18], DM, DFF, (bf16*)(F.ws + WS_WFF1), scr, r, lane); continue; } r -= I_F1;
        p0_transpose_item(F.in[19], DFF, DM, (bf16*)(F.ws + WS_WFF2), scr, r, lane);
    }
}

__device__ __forceinline__ void p1_prep(Frame& F) {
    const int tid = opaque_tid(), lane = tid & 63, wave = __builtin_amdgcn_readfirstlane(tid >> 6); (void)lane; (void)wave;
    const float* M_ADA = (const float*)(F.ws + WS_SMALL + SM_ADA);
    bf16* XM = (bf16*)(F.ws + WS_XM);
    const int gw = F.vcu * NWAVES + wave, NGW = F.G * NWAVES;
    for (int row = gw; row < MT; row += NGW) {
        const float* src; int mr;
        if (row < ML) { src = F.in[0] + (size_t)row * DM; mr = row >> 11; } else { src = F.in[2] + (size_t)(row - ML) * DM; mr = 8; }
        const float* sh = M_ADA + (size_t)mr * NADA; const float* sc = sh + DM;
        GAS v2u* o8 = (GAS v2u*)(XM + (size_t)row * DM) + lane;
#pragma unroll
        for (int j = 0; j < 8; ++j) { const int col = 4 * lane + 256 * j;
            const f32x4 xv = *(const GAS f32x4*)(src + col), s1 = *(const GAS f32x4*)(sc + col), s0 = *(const GAS f32x4*)(sh + col);
            const f32x4 y = xv * (s1 + 1.f) + s0;
            v2u w; w.x = pk2(y[0], y[1]); w.y = pk2(y[2], y[3]); o8[64 * j] = w; }
    }
}

__device__ __forceinline__ void hgrn_unit_seq(Frame& F, const bf16* QH, const bf16* LFG, const bf16* IH, float* OUT, int b, int h, int dir) {
    const int tid = opaque_tid(), lane = tid & 63, wave = __builtin_amdgcn_readfirstlane(tid >> 6); (void)lane; (void)wave;
    LAS float* qs = (LAS float*)F.lds; LAS float* fs = qs + 16 * 128; LAS float* ks = fs + 16 * 128; LAS float* vs = ks + 16 * 128; LAS float* opart = vs + 16 * 128;
    const int v = tid & 127, dq = tid >> 7, tk_l = tid >> 5, ch4 = (tid & 31) * 4;
    float S[32];
#pragma unroll
    for (int i = 0; i < 32; ++i) S[i] = 0.f;
    for (int n0 = 0; n0 < CTX + SEQ; n0 += 16) {
        { const int n = n0 + tk_l; size_t row;
          if (n < CTX) row = (size_t)ML + (size_t)b * CTX + (dir ? CTX - 1 - n : n); else { const int tl = n - CTX; row = (size_t)b * SEQ + (dir ? SEQ - 1 - tl : tl); }
          const size_t off = row * GW + h * HD + ch4;
          const v2u qw = *(const GAS v2u*)(QH + off), lw = *(const GAS v2u*)(LFG + off), vw = *(const GAS v2u*)(IH + off);
          const f32x4 qv = {bf_lo(qw.x), bf_hi(qw.x), bf_lo(qw.y), bf_hi(qw.y)}, lv = {bf_lo(lw.x), bf_hi(lw.x), bf_lo(lw.y), bf_hi(lw.y)}, vv = {bf_lo(vw.x), bf_hi(vw.x), bf_lo(vw.y), bf_hi(vw.y)};
          f32x4 fv, kv;
#pragma unroll
          for (int j = 0; j < 4; ++j) { fv[j] = expf(lv[j]); kv[j] = -expm1f(lv[j]); }
          *(LAS f32x4*)(qs + tk_l * 128 + ch4) = qv; *(LAS f32x4*)(fs + tk_l * 128 + ch4) = fv; *(LAS f32x4*)(ks + tk_l * 128 + ch4) = kv; *(LAS f32x4*)(vs + tk_l * 128 + ch4) = vv; }
        __syncthreads();
#pragma unroll 2
        for (int tk = 0; tk < 16; ++tk) {
            const float vv = vs[tk * 128 + v]; float op = 0.f;
#pragma unroll
            for (int i = 0; i < 32; i += 4) {
                const f32x4 f4 = *(const LAS f32x4*)(fs + tk * 128 + 32 * dq + i), k4 = *(const LAS f32x4*)(ks + tk * 128 + 32 * dq + i), q4 = *(const LAS f32x4*)(qs + tk * 128 + 32 * dq + i);
#pragma unroll
                for (int j = 0; j < 4; ++j) { S[i + j] = f4[j] * S[i + j] + k4[j] * vv; op += S[i + j] * q4[j]; }
            }
            opart[(tk * 4 + dq) * 128 + v] = op;
        }
        __syncthreads();
        if (n0 >= CTX) { const int tl = n0 + tk_l - CTX; const size_t row = (size_t)b * SEQ + (dir ? SEQ - 1 - tl : tl);
            f32x4 s = *(const LAS f32x4*)(opart + (tk_l * 4 + 0) * 128 + ch4);
#pragma unroll
            for (int d = 1; d < 4; ++d) s = s + *(const LAS f32x4*)(opart + (tk_l * 4 + d) * 128 + ch4);
            *(GAS f32x4*)(OUT + row * GW + h * HD + ch4) = s; }
        __syncthreads();
    }
}

__device__ __forceinline__ void p3_mixer(Frame& F, unsigned char* lds_generic, unsigned myx) {
    const int tid = opaque_tid(), lane = tid & 63, wave = __builtin_amdgcn_readfirstlane(tid >> 6); (void)lane; (void)wave;
    const bf16* P = (const bf16*)(F.ws + WS_P);
    bf16* MIXED = (bf16*)(F.ws + WS_XM);
    float lam;
    { const float a = (lane < 64) ? F.in[7][lane] * F.in[8][lane] : 0.f, c2 = F.in[9][lane] * F.in[10][lane];
      lam = expf(wave_sum(a)) - expf(wave_sum(c2)) + LAM_INIT; }
    for (;;) {
        __syncthreads();
        if (tid == 0) { int code = -1;
            for (int k = 0; k < 8; ++k) { const unsigned x = (myx + (unsigned)k) & 7u; const unsigned n = __hip_atomic_fetch_add(F.ctl + CW_Q + 64 * x, 1u, RLX_AGENT); if (n < 144u) { code = (int)(x * 144u + n); break; } }
            F.MISC[4] = (unsigned)code; }
        __syncthreads();
        const int code = (int)F.MISC[4];
        if (code < 0) break;
        const int x = code / 144, n = code % 144;
        if (n < 16) { const int u = x + 8 * n, bh = u >> 1, dir = u & 1;
            hgrn_unit_seq(F, P + G_QH * GSTRIDE, P + (dir ? G_ZB : G_ZF) * GSTRIDE, P + G_IH * GSTRIDE, F.out + (size_t)dir * ML * GW, bh >> 3, bh & 7, dir);
        } else { const int j = n - 16, bh = x + 8 * (j >> 4), qb = j & 15;
            da::attn_unit((char*)lds_generic, P + G_QD * GSTRIDE, P + G_KD * GSTRIDE, P + G_VD * GSTRIDE, MIXED, F.in[11], bh >> 3, bh & 7, qb, lam);
        }
    }
}

__device__ __forceinline__ void p3b_combine(Frame& F) {
    const int tid = opaque_tid(), lane = tid & 63, wave = __builtin_amdgcn_readfirstlane(tid >> 6); (void)lane; (void)wave;
    const float* OF = F.out; const float* OB = F.out + (size_t)ML * GW;
    const bf16* GH = (const bf16*)(F.ws + WS_P) + G_GH * GSTRIDE;
    bf16* MIXED = (bf16*)(F.ws + WS_XM);
    const float* hw = F.in[14];
    const int gw = F.vcu * NWAVES + wave, NGW = F.G * NWAVES, c0 = 16 * lane;
    f32x4 w4[4];
#pragma unroll
    for (int i = 0; i < 4; ++i) w4[i] = *(const GAS f32x4*)(hw + (c0 & 127) + 4 * i);
    for (int row = gw; row < ML; row += NGW) {
        f32x4 o[4]; float ss = 0.f;
#pragma unroll
        for (int i = 0; i < 4; ++i) { o[i] = *(const GAS f32x4*)(OF + (size_t)row * GW + c0 + 4 * i) + *(const GAS f32x4*)(OB + (size_t)row * GW + c0 + 4 * i);
            ss += (o[i][0] * o[i][0] + o[i][1] * o[i][1]) + (o[i][2] * o[i][2] + o[i][3] * o[i][3]); }
        ss += __shfl_xor(ss, 1); ss += __shfl_xor(ss, 2); ss += __shfl_xor(ss, 4);
        const float rs = 1.f / sqrtf(ss * (1.f / 128.f) + LN_EPS);
        const v4u g0 = *(const GAS v4u*)(GH + (size_t)row * GW + c0), g1 = *(const GAS v4u*)(GH + (size_t)row * GW + c0 + 8);
        const unsigned gw_[8] = {g0.x, g0.y, g0.z, g0.w, g1.x, g1.y, g1.z, g1.w};
        unsigned ow[8];
#pragma unroll
        for (int i = 0; i < 4; ++i) {
            const float a0 = o[i][0] * rs * w4[i][0] * bf_lo(gw_[2 * i]), a1 = o[i][1] * rs * w4[i][1] * bf_hi(gw_[2 * i]);
            const float a2 = o[i][2] * rs * w4[i][2] * bf_lo(gw_[2 * i + 1]), a3 = o[i][3] * rs * w4[i][3] * bf_hi(gw_[2 * i + 1]);
            ow[2 * i] = pk2(a0, a1); ow[2 * i + 1] = pk2(a2, a3); }
        bf16* op = MIXED + (size_t)row * DM + GW + c0;
        *(GAS v4u*)op = (v4u){ow[0], ow[1], ow[2], ow[3]}; *(GAS v4u*)(op + 8) = (v4u){ow[4], ow[5], ow[6], ow[7]};
    }
}

template <bool WITH_U>
__device__ __forceinline__ void ln_pass(Frame& F, const float* g, const float* bta) {
    const int tid = opaque_tid(), lane = tid & 63, wave = __builtin_amdgcn_readfirstlane(tid >> 6); (void)lane; (void)wave;
    const float* M_ADA = (const float*)(F.ws + WS_SMALL + SM_ADA);
    bf16* U = (bf16*)(F.ws + WS_U);
    const int gw = F.vcu * NWAVES + wave, NGW = F.G * NWAVES;
    for (int row = gw; row < ML; row += NGW) {
        GAS f32x4* xr = (GAS f32x4*)(F.out + (size_t)row * DM) + lane;
        f32x4 v[8]; float s = 0.f;
#pragma unroll
        for (int j = 0; j < 8; ++j) { v[j] = xr[64 * j]; s += (v[j][0] + v[j][1]) + (v[j][2] + v[j][3]); }
        const float mean = wave_sum(s) * (1.f / DM); float s2 = 0.f;
#pragma unroll
        for (int j = 0; j < 8; ++j) { v[j] = v[j] - mean; s2 += (v[j][0] * v[j][0] + v[j][1] * v[j][1]) + (v[j][2] * v[j][2] + v[j][3] * v[j][3]); }
        const float rstd = 1.f / sqrtf(wave_sum(s2) * (1.f / DM) + LN_EPS);
        const float* sh = M_ADA + (size_t)(row >> 11) * NADA + 3 * DM; const float* sc = sh + DM;
        GAS v2u* o8 = (GAS v2u*)(U + (size_t)row * DM) + lane;
#pragma unroll
        for (int j = 0; j < 8; ++j) { const int col = 4 * lane + 256 * j;
            const f32x4 hv = v[j] * rstd * *(const GAS f32x4*)(g + col) + *(const GAS f32x4*)(bta + col);
            xr[64 * j] = hv;
            if (WITH_U) { const f32x4 y = hv * (*(const GAS f32x4*)(sc + col) + 1.f) + *(const GAS f32x4*)(sh + col);
                v2u w; w.x = pk2(y[0], y[1]); w.y = pk2(y[2], y[3]); o8[64 * j] = w; } }
    }
}

struct Args { const float* in[22]; float* out; unsigned char* ws; };
__global__ void __launch_bounds__(NWAVES * 64, 2) mega_fwd(Args args) {
    extern __shared__ __attribute__((aligned(16))) unsigned char lds[];
    Frame F;
    F.lds = (LAS unsigned char*)lds;
    F.MISC = (volatile LAS unsigned*)(F.lds + LDSCTL_OFF);
    const int tid = threadIdx.x;
    F.G = gridDim.x; { const int bx = blockIdx.x; F.vcu = (F.G % 8 == 0) ? (bx % 8) * (F.G / 8) + bx / 8 : bx; }
    F.ws = args.ws; F.out = args.out; F.ctl = (gu32*)(args.ws + WS_CTL);
#pragma unroll
    for (int i = 0; i < 22; ++i) F.in[i] = args.in[i];
    for (int u = tid; u < (LDS_BYTES - LDSCTL_OFF) / 4; u += NWAVES * 64) ((LAS unsigned*)(F.lds + LDSCTL_OFF))[u] = 0u;
    __syncthreads();
    XcdBarrier bar = xcd_barrier_post((unsigned*)(F.ctl + CW_BAR), F.MISC + 8);
#define GRID_BAR() xcd_barrier(bar)
    const float* M_ADA = (const float*)(F.ws + WS_SMALL + SM_ADA);

    p0_prologue(F); GRID_BAR();
    p1_prep(F); GRID_BAR();
    {
        pg8::Gemm g{(const pg8::bf16_t*)(F.ws + WS_XM), (const pg8::bf16_t*)(F.ws + WS_WIN), MT, NIN, DM}; pg8::StaticOrder S; S.init(MT, NIN, F.G, (int)blockIdx.x);
        pg8::EpiInProj E{(pg8::bf16_t*)(F.ws + WS_P), (const float*)(F.ws + WS_SMALL + SM_ROPE), (const float*)(F.ws + WS_SMALL + SM_LBF), (const float*)(F.ws + WS_SMALL + SM_LBB)};
        pg8::gemm_phase<pg8::EpiInProj, pg8::StaticOrder, true, true>(F.lds, g, S, E);
    }
    GRID_BAR();
    p3_mixer(F, lds, bar.x & 7u); GRID_BAR();
    p3b_combine(F); GRID_BAR();
    {
        pg8::Gemm g{(const pg8::bf16_t*)(F.ws + WS_XM), (const pg8::bf16_t*)(F.ws + WS_WOUT), ML, DM, DM}; pg8::StaticOrder S; S.init(ML, DM, F.G, (int)blockIdx.x);
        pg8::EpiResid E{F.in[0], F.out, M_ADA + 2 * DM};
        pg8::gemm_phase<pg8::EpiResid, pg8::StaticOrder, true, true>(F.lds, g, S, E);
    }
    GRID_BAR();
    ln_pass<true>(F, F.in[16], F.in[17]); GRID_BAR();
    {
        pg8::Gemm g{(const pg8::bf16_t*)(F.ws + WS_U), (const pg8::bf16_t*)(F.ws + WS_WFF1), ML, DFF, DM}; pg8::StaticOrder S; S.init(ML, DFF, F.G, (int)blockIdx.x);
        pg8::EpiRelu2 E{(pg8::bf16_t*)(F.ws + WS_H), DFF};
        pg8::gemm_phase<pg8::EpiRelu2, pg8::StaticOrder, true, true>(F.lds, g, S, E);
    }
    GRID_BAR();
    {
        pg8::Gemm g{(const pg8::bf16_t*)(F.ws + WS_H), (const pg8::bf16_t*)(F.ws + WS_WFF2), ML, DM, DFF}; pg8::StaticOrder S; S.init(ML, DM, F.G, (int)blockIdx.x);
        pg8::EpiResid E{F.out, F.out, M_ADA + 5 * DM};
        pg8::gemm_phase<pg8::EpiResid, pg8::StaticOrder, true, true>(F.lds, g, S, E);
    }
    GRID_BAR();
    ln_pass<false>(F, F.in[20], F.in[21]);
#undef GRID_BAR
}

extern "C" void kernel_launch(void* const* d_in, const int* in_sizes, int n_in, void* d_out, int out_size, void* d_ws, size_t ws_size, hipStream_t stream) {
    static int grid = 0;
    if (grid == 0) {
        if (n_in != 22 || in_sizes[0] != ML * DM || out_size != ML * DM || ws_size < WS_END) {
            fprintf(stderr, "kernel_launch: built for 22 inputs, x and out of %d floats, >= %zu bytes of workspace; got n_in %d, in0 %d, out %d, ws %zu; nothing launched\n", ML * DM, (size_t)WS_END, n_in, n_in > 0 ? in_sizes[0] : -1, out_size, ws_size); grid = -1; return; }
        int dev = 0, cus = 0, per_cu = 0;
        if (hipGetDevice(&dev) != hipSuccess || hipDeviceGetAttribute(&cus, hipDeviceAttributeMultiprocessorCount, dev) != hipSuccess) { fprintf(stderr, "kernel_launch: device query failed\n"); grid = -1; return; }
        if (hipFuncSetAttribute((const void*)mega_fwd, hipFuncAttributeMaxDynamicSharedMemorySize, LDS_BYTES) != hipSuccess) { fprintf(stderr, "kernel_launch: hipFuncSetAttribute failed\n"); grid = -1; return; }
        if (hipOccupancyMaxActiveBlocksPerMultiprocessor(&per_cu, (const void*)mega_fwd, NWAVES * 64, LDS_BYTES) != hipSuccess || per_cu < 1)
            fprintf(stderr, "kernel_launch: note: occupancy query reports %d workgroups per CU\n", per_cu);
        (void)hipGetLastError();
        grid = cus;
        if (grid % 8 != 0) grid -= grid % 8;
    }
    if (grid < 0) return;
    if (hipMemsetAsync((char*)d_ws + WS_CTL, 0, CTL_ZERO_BYTES, stream) != hipSuccess) { fprintf(stderr, "kernel_launch: hipMemsetAsync failed\n"); return; }
    Args a{};
    for (int i = 0; i < 22; ++i) a.in[i] = (const float*)d_in[i];
    a.out = (float*)d_out; a.ws = (unsigned char*)d_ws;
    hipLaunchKernelGGL(mega_fwd, dim3(grid), dim3(NWAVES * 64), LDS_BYTES, stream, a);
    const hipError_t le = hipPeekAtLastError();
    if (le != hipSuccess) fprintf(stderr, "kernel_launch: launch failed: %s\n", hipGetErrorName(le));
}
```

```cpp
#include <hip/hip_runtime.h>
#include <hip/hip_bf16.h>
#include <cstdio>
#include <cstdint>
#include <cmath>

constexpr int DM = 2048, NB = 8, SEQ = 2048, CTX = 256, NHEAD = 8, HD = 128;
constexpr int ML = NB * SEQ;
constexpr int MC = NB * CTX;
constexpr int MT = ML + MC;
constexpr int NIN = 8192, GW = 1024, DFF = 8192, NADA = 6 * DM;
constexpr float LN_EPS = 1e-5f;
constexpr float ALPHA_RES = 1.189207115002721f;
constexpr float ONE_M_LAMINIT = 0.8f;
constexpr float LAM_INIT = 0.2f;
constexpr size_t GSTRIDE = (size_t)MT * GW;
enum { G_QD = 0, G_KD = 1, G_VD = 2, G_QH = 3, G_ZF = 4, G_ZB = 5, G_IH = 6, G_GH = 7 };
typedef float f32x2g __attribute__((ext_vector_type(2)));
namespace pg8 {
#define PG8_LAS __attribute__((address_space(3)))
typedef unsigned short bf16_t;
typedef short bf16x8 __attribute__((ext_vector_type(8)));
typedef float f32x4 __attribute__((ext_vector_type(4)));
typedef unsigned u32x4 __attribute__((ext_vector_type(4)));
constexpr int BM = 256, BK = 64, HALF = 128, HTB = HALF * BK * 2  , STAGE_BYTES = 8 * HTB, NXCD = 8, WGM = 8;

__host__ __device__ __forceinline__ int lds_byte(int r, int c) { const int st = (r >> 4) * 2 + (c >> 5), rr = r & 15, cc = c & 31, ob = rr * 64 + cc * 2; return st * 1024 + (ob ^ (((ob >> 9) & 1) << 5)); }
__host__ __device__ __forceinline__ void stage_rc(int b, int& R, int& C) { const int st = b / 1024, sb = b % 1024, swz = sb ^ (((sb >> 9) & 1) << 5); R = (st >> 1) * 16 + swz / 64; C = (st & 1) * 32 + (swz % 64) / 2; }
__host__ __device__ __forceinline__ int perm32(int rho) { const int n = rho >> 4, i = rho & 15; return 8 * (i >> 2) + 4 * n + (i & 3); }

struct Unit { int pm, pn; };
struct Gemm { const bf16_t* A; const bf16_t* Bt; int M, N, K; };

struct StaticOrder {
    int nM, nN, nwg, G, c;
    __host__ __device__ void init(int M, int N, int G_, int c_) { nM = M / BM; nN = N / BM; nwg = nM * nN; G = G_; c = c_; }
    __host__ __device__ bool next(int i, Unit& u) const {
        const long L = (long)i * G + c; if (L >= nwg) return false;
        int wgid = (int)L; { const int q = nwg / NXCD, r = nwg % NXCD, xcd = wgid % NXCD, off = wgid / NXCD; wgid = (xcd < r ? xcd * (q + 1) : r * (q + 1) + (xcd - r) * q) + off; }
        const int nig = WGM * nN, gid = wgid / nig, fm = gid * WGM, gsz = (nM - fm) < WGM ? (nM - fm) : WGM;
        u.pm = fm + ((wgid % nig) % gsz); u.pn = (wgid % nig) / gsz; return true;
    }
    __device__ __forceinline__ void a_ready(const Unit&) const {}
    __device__ __forceinline__ void done(const Unit&) const {}
};

__device__ __forceinline__ unsigned cvt_pk_bf16(float lo, float hi) { unsigned r; asm volatile("v_cvt_pk_bf16_f32 %0, %1, %2" : "=v"(r) : "v"(lo), "v"(hi)); return r; }
__device__ __forceinline__ float sigmoid_f(float z) { return __builtin_amdgcn_rcpf(1.0f + __builtin_amdgcn_exp2f(-1.4426950408889634f * z)); }
__device__ __forceinline__ void store8_bf16(bf16_t* p, f32x4 v0, f32x4 v1) {
    u32x4 w; w.x = cvt_pk_bf16(v0[0], v0[1]); w.y = cvt_pk_bf16(v0[2], v0[3]); w.z = cvt_pk_bf16(v1[0], v1[1]); w.w = cvt_pk_bf16(v1[2], v1[3]); *(u32x4*)p = w; }

struct EpiInProj {
    static constexpr bool PERM = true, AFTER_DRAIN = false;
    bf16_t* P; const float* rope; const float* lbf; const float* lbb;
    __device__ __forceinline__ void operator()(const f32x4 (&acc)[2][2][4][2], const Unit& u, int wr, int wc, int fr, int fq) const {
        const int g = u.pn >> 2;
        bf16_t* base = P + (size_t)g * GSTRIDE;
        const int row0 = u.pm * BM + wr * 64 + fr;
        const int col0 = (u.pn & 3) * BM + wc * 32 + 8 * fq;
        if (g <= G_KD && u.pm < ML / BM) {
            const float sgn = (fq < 2) ? -1.f : 1.f;
#pragma unroll
            for (int ai = 0; ai < 2; ++ai)
#pragma unroll
                for (int m = 0; m < 4; ++m) {
                    const int row = row0 + ai * HALF + m * 16; const int t = row & (SEQ - 1);
                    const int pos = (wc & 1) ? (t & 63) : (t >> 6);
                    const f32x4* tp = (const f32x4*)(rope + (size_t)(pos * 16 + 8 * (fq & 1)) * 2);
                    const f32x4 t0 = tp[0], t1 = tp[1], t2 = tp[2], t3 = tp[3];
                    bf16_t* rowp = base + (size_t)row * GW + col0;
#pragma unroll
                    for (int bj = 0; bj < 2; ++bj) {
                        const f32x4 v0 = acc[ai][bj][m][0], v1 = acc[ai][bj][m][1];
                        f32x4 p0, p1;
#pragma unroll
                        for (int j = 0; j < 4; ++j) { p0[j] = sgn * __shfl_xor(v0[j], 32); p1[j] = sgn * __shfl_xor(v1[j], 32); }
                        f32x4 o0, o1;
                        o0[0] = v0[0] * t0[0] + p0[0] * t0[1]; o0[1] = v0[1] * t0[2] + p0[1] * t0[3];
                        o0[2] = v0[2] * t1[0] + p0[2] * t1[1]; o0[3] = v0[3] * t1[2] + p0[3] * t1[3];
                        o1[0] = v1[0] * t2[0] + p1[0] * t2[1]; o1[1] = v1[1] * t2[2] + p1[1] * t2[3];
                        o1[2] = v1[2] * t3[0] + p1[2] * t3[1]; o1[3] = v1[3] * t3[2] + p1[3] * t3[3];
                        store8_bf16(rowp + bj * HALF, o0, o1);
                    }
                }
        } else if (g == G_QH || g == G_GH) {
#pragma unroll
            for (int ai = 0; ai < 2; ++ai)
#pragma unroll
                for (int m = 0; m < 4; ++m) { bf16_t* rowp = base + (size_t)(row0 + ai * HALF + m * 16) * GW + col0;
#pragma unroll
                    for (int bj = 0; bj < 2; ++bj) { f32x4 v0 = acc[ai][bj][m][0], v1 = acc[ai][bj][m][1];
#pragma unroll
                        for (int j = 0; j < 4; ++j) { v0[j] = v0[j] * sigmoid_f(v0[j]); v1[j] = v1[j] * sigmoid_f(v1[j]); }
                        store8_bf16(rowp + bj * HALF, v0, v1); } }
        } else if (g == G_ZF || g == G_ZB) {
            const float* lbv = (g == G_ZF ? lbf : lbb) + col0;
            f32x4 lb[2][2];
#pragma unroll
            for (int bj = 0; bj < 2; ++bj) { lb[bj][0] = *(const f32x4*)(lbv + bj * HALF); lb[bj][1] = *(const f32x4*)(lbv + bj * HALF + 4); }
#pragma unroll
            for (int ai = 0; ai < 2; ++ai)
#pragma unroll
                for (int m = 0; m < 4; ++m) { bf16_t* rowp = base + (size_t)(row0 + ai * HALF + m * 16) * GW + col0;
#pragma unroll
                    for (int bj = 0; bj < 2; ++bj) { f32x4 v0 = acc[ai][bj][m][0], v1 = acc[ai][bj][m][1];
#pragma unroll
                        for (int j = 0; j < 4; ++j) {
                            const float l0 = lb[bj][0][j], l1 = lb[bj][1][j];
                            v0[j] = 0.6931471805599453f * __builtin_amdgcn_logf(l0 + (1.f - l0) * sigmoid_f(v0[j]));
                            v1[j] = 0.6931471805599453f * __builtin_amdgcn_logf(l1 + (1.f - l1) * sigmoid_f(v1[j])); }
                        store8_bf16(rowp + bj * HALF, v0, v1); } }
        } else {
#pragma unroll
            for (int ai = 0; ai < 2; ++ai)
#pragma unroll
                for (int m = 0; m < 4; ++m) { bf16_t* rowp = base + (size_t)(row0 + ai * HALF + m * 16) * GW + col0;
#pragma unroll
                    for (int bj = 0; bj < 2; ++bj) store8_bf16(rowp + bj * HALF, acc[ai][bj][m][0], acc[ai][bj][m][1]); }
        }
    }
};
struct EpiResid {
    static constexpr bool PERM = false, AFTER_DRAIN = false;
    const float* base; float* out; const float* gate;
    __device__ __forceinline__ void operator()(const f32x4 (&acc)[2][2][4][2], const Unit& u, int wr, int wc, int fr, int fq) const {
        const int row0 = u.pm * BM + wr * 64 + fr, col0 = u.pn * BM + wc * 32 + 4 * fq;
        const float* gp = gate + (size_t)(u.pm >> 3) * NADA + col0;
        f32x4 gv[2][2];
#pragma unroll
        for (int bj = 0; bj < 2; ++bj)
#pragma unroll
            for (int n = 0; n < 2; ++n) gv[bj][n] = *(const f32x4*)(gp + bj * HALF + n * 16);
#pragma unroll
        for (int ai = 0; ai < 2; ++ai)
#pragma unroll
            for (int m = 0; m < 4; ++m) { const size_t off = (size_t)(row0 + ai * HALF + m * 16) * DM + col0;
#pragma unroll
                for (int bj = 0; bj < 2; ++bj)
#pragma unroll
                    for (int n = 0; n < 2; ++n) { const f32x4 bs = *(const f32x4*)(base + off + bj * HALF + n * 16);
                        *(f32x4*)(out + off + bj * HALF + n * 16) = bs * ALPHA_RES + gv[bj][n] * acc[ai][bj][m][n]; } }
    }
};
struct EpiRelu2 {
    static constexpr bool PERM = true, AFTER_DRAIN = false;
    bf16_t* O; int ldc;
    __device__ __forceinline__ void operator()(const f32x4 (&acc)[2][2][4][2], const Unit& u, int wr, int wc, int fr, int fq) const {
        const int row0 = u.pm * BM + wr * 64 + fr, col0 = u.pn * BM + wc * 32 + 8 * fq;
#pragma unroll
        for (int ai = 0; ai < 2; ++ai)
#pragma unroll
            for (int m = 0; m < 4; ++m) { bf16_t* rowp = O + (size_t)(row0 + ai * HALF + m * 16) * ldc + col0;
#pragma unroll
                for (int bj = 0; bj < 2; ++bj) { f32x4 v0 = acc[ai][bj][m][0], v1 = acc[ai][bj][m][1];
#pragma unroll
                    for (int j = 0; j < 4; ++j) { const float a = fmaxf(v0[j], 0.f), b = fmaxf(v1[j], 0.f); v0[j] = a * a; v1[j] = b * b; }
                    store8_bf16(rowp + bj * HALF, v0, v1); } }
    }
};

template <class Epi, class Sched, bool ALIGN_EPI = false, bool SP2 = false>
__device__ __forceinline__ void gemm_phase(PG8_LAS unsigned char* lds, const Gemm g, const Sched& S, const Epi& E) {
    int tid_ = threadIdx.x; asm volatile("" : "+v"(tid_));
    const int tid = tid_, wid = __builtin_amdgcn_readfirstlane(tid >> 6), lane = tid & 63, wr = wid >> 2, wc = wid & 3, fr = lane & 15, fq = lane >> 4;
    const int K = g.K, nt = K / BK;
    unsigned voffA[2], voffB[2];
#pragma unroll
    for (int i = 0; i < 2; ++i) { int R, C; stage_rc(tid * 16 + i * 8192, R, C); const int Rb = Epi::PERM ? ((R & ~31) + perm32(R & 31)) : R;
        voffA[i] = (unsigned)(R * K + C) * 2u; voffB[i] = (unsigned)(Rb * K + C) * 2u; }
    const size_t kstep = (size_t)(BK * 2);
    const size_t hstep = (size_t)HALF * K * 2;
    const size_t tstep = 2 * hstep;
    const unsigned ldsw = (unsigned)wid * 1024u;
    const int aoff = lds_byte(wr * 64 + fr, fq * 8), boff = lds_byte(wc * 32 + fr, fq * 8);
#define PG8_SA(b, h) (((b) * 2 + (h)) * HTB)
#define PG8_SB(b, h) ((4 + (b) * 2 + (h)) * HTB)
#define PG8_STAGE(bufoff, gbase, voff) do { _Pragma("unroll") for (int _i = 0; _i < 2; ++_i) \
        __builtin_amdgcn_global_load_lds((const unsigned*)((const char*)(gbase) + (voff)[_i]), (PG8_LAS unsigned*)(lds + (bufoff) + ldsw + _i * 8192), 16, 0, 0); } while (0)
#define PG8_LDA(dst, b, h) do { _Pragma("unroll") for (int m = 0; m < 4; ++m) _Pragma("unroll") for (int k = 0; k < 2; ++k) dst[m][k] = *(const PG8_LAS bf16x8*)(lds + PG8_SA(b, h) + aoff + m * 2048 + k * 1024); } while (0)
#define PG8_LDB(dst, b, h) do { _Pragma("unroll") for (int n = 0; n < 2; ++n) _Pragma("unroll") for (int k = 0; k < 2; ++k) dst[n][k] = *(const PG8_LAS bf16x8*)(lds + PG8_SB(b, h) + boff + n * 2048 + k * 1024); } while (0)
#define PG8_MMA(ai, bj, At, Bt) do { __builtin_amdgcn_s_setprio(1); _Pragma("unroll") for (int m = 0; m < 4; ++m) _Pragma("unroll") for (int n = 0; n < 2; ++n) _Pragma("unroll") for (int k = 0; k < 2; ++k) \
        acc[ai][bj][m][n] = __builtin_amdgcn_mfma_f32_16x16x32_bf16(Bt[n][k], At[m][k], acc[ai][bj][m][n], 0, 0, 0); __builtin_amdgcn_s_setprio(0); } while (0)
#define PG8_WAIT_V(n) asm volatile("s_waitcnt vmcnt(" #n ")" ::: "memory")
#define PG8_WAIT_L(n) asm volatile("s_waitcnt lgkmcnt(" #n ")" ::: "memory")
#define PG8_BAR __builtin_amdgcn_s_barrier()
#define PG8_SCHED __builtin_amdgcn_sched_barrier(0)
    Unit cur, nxt; int ui = 0;
    if (!S.next(0, cur)) return;
    f32x4 acc[2][2][4][2];
#pragma unroll
    for (int a = 0; a < 2; ++a)
#pragma unroll
        for (int b = 0; b < 2; ++b)
#pragma unroll
            for (int m = 0; m < 4; ++m)
#pragma unroll
                for (int n = 0; n < 2; ++n) acc[a][b][m][n] = (f32x4){0.f, 0.f, 0.f, 0.f};
    bf16x8 At[4][2], B0[2][2], B1[2][2];
    const char* cA = (const char*)g.A + (size_t)cur.pm * tstep; const char* cB = (const char*)g.Bt + (size_t)cur.pn * tstep;
    S.a_ready(cur);
    if constexpr (SP2) {
        PG8_STAGE(PG8_SB(0, 0), cB, voffB); PG8_STAGE(PG8_SB(0, 1), cB + hstep, voffB); PG8_STAGE(PG8_SA(0, 0), cA, voffA); PG8_STAGE(PG8_SA(0, 1), cA + hstep, voffA);
        if (wr == 1) PG8_BAR;
        PG8_WAIT_V(2); PG8_BAR;
        PG8_STAGE(PG8_SB(1, 0), cB + kstep, voffB); PG8_STAGE(PG8_SA(1, 0), cA + kstep, voffA); PG8_STAGE(PG8_SB(1, 1), cB + hstep + kstep, voffB);
        PG8_WAIT_V(6); PG8_BAR;
    } else {
        PG8_STAGE(PG8_SB(0, 0), cB, voffB); PG8_STAGE(PG8_SA(0, 0), cA, voffA); PG8_STAGE(PG8_SB(0, 1), cB + hstep, voffB); PG8_STAGE(PG8_SA(0, 1), cA + hstep, voffA);
        if (wr == 1) PG8_BAR;
        PG8_WAIT_V(4); PG8_BAR;
        PG8_STAGE(PG8_SB(1, 0), cB + kstep, voffB); PG8_STAGE(PG8_SA(1, 0), cA + kstep, voffA); PG8_STAGE(PG8_SB(1, 1), cB + hstep + kstep, voffB);
        PG8_WAIT_V(6); PG8_BAR;
    }
    for (;;) {
        const bool has_next = S.next(ui + 1, nxt);
        const char* nA = has_next ? (const char*)g.A + (size_t)nxt.pm * tstep : cA; const char* nB = has_next ? (const char*)g.Bt + (size_t)nxt.pn * tstep : cB;
        for (int t = 0; t < nt; t += 2) {
            const bool last = (t == nt - 2);
            const char* a1 = cA + (size_t)(t + 1) * kstep;
            const char* a2 = last ? nA : cA + (size_t)(t + 2) * kstep; const char* b2 = last ? nB : cB + (size_t)(t + 2) * kstep;
            const char* a3 = a2 + kstep; const char* b3 = b2 + kstep;
            if (last && has_next) S.a_ready(nxt);
            if constexpr (SP2) {
            PG8_LDB(B0, 0, 0); PG8_LDB(B1, 0, 1); PG8_SCHED; PG8_LDA(At, 0, 0); PG8_STAGE(PG8_SA(1, 1), a1 + hstep, voffA);
            PG8_WAIT_V(8); PG8_WAIT_L(0); PG8_BAR; PG8_MMA(0, 0, At, B0); PG8_MMA(0, 1, At, B1); PG8_BAR; PG8_SCHED;
            PG8_LDA(At, 0, 1); PG8_STAGE(PG8_SB(0, 0), b2, voffB); PG8_STAGE(PG8_SB(0, 1), b2 + hstep, voffB); PG8_STAGE(PG8_SA(0, 0), a2, voffA);
            PG8_WAIT_V(8); PG8_WAIT_L(0); PG8_BAR; PG8_MMA(1, 0, At, B0); PG8_MMA(1, 1, At, B1); PG8_BAR; PG8_SCHED;
            PG8_LDB(B0, 1, 0); PG8_LDB(B1, 1, 1); PG8_SCHED; PG8_LDA(At, 1, 0); PG8_STAGE(PG8_SA(0, 1), a2 + hstep, voffA);
            PG8_WAIT_V(8); PG8_WAIT_L(0); PG8_BAR; PG8_MMA(0, 0, At, B0); PG8_MMA(0, 1, At, B1); PG8_BAR; PG8_SCHED;
            PG8_LDA(At, 1, 1); PG8_STAGE(PG8_SB(1, 0), b3, voffB); PG8_STAGE(PG8_SB(1, 1), b3 + hstep, voffB); PG8_STAGE(PG8_SA(1, 0), a3, voffA);
            PG8_WAIT_V(8); PG8_WAIT_L(0); PG8_BAR; PG8_MMA(1, 0, At, B0); PG8_MMA(1, 1, At, B1); PG8_BAR; PG8_SCHED;
            } else {
            PG8_LDB(B0, 0, 0); PG8_SCHED; PG8_LDA(At, 0, 0); PG8_STAGE(PG8_SA(1, 1), a1 + hstep, voffA);
            PG8_WAIT_L(8); PG8_BAR; PG8_WAIT_L(0); PG8_MMA(0, 0, At, B0); PG8_BAR; PG8_SCHED;
            PG8_LDB(B1, 0, 1); PG8_STAGE(PG8_SB(0, 0), b2, voffB);
            PG8_BAR; PG8_WAIT_L(0); PG8_MMA(0, 1, At, B1); PG8_BAR;
            PG8_LDA(At, 0, 1); PG8_STAGE(PG8_SA(0, 0), a2, voffA);
            PG8_BAR; PG8_WAIT_L(0); PG8_MMA(1, 0, At, B0); PG8_BAR; PG8_SCHED;
            PG8_STAGE(PG8_SB(0, 1), b2 + hstep, voffB);
            PG8_WAIT_V(6); PG8_BAR; PG8_MMA(1, 1, At, B1); PG8_BAR;
            PG8_LDB(B0, 1, 0); PG8_SCHED; PG8_LDA(At, 1, 0); PG8_STAGE(PG8_SA(0, 1), a2 + hstep, voffA);
            PG8_WAIT_L(8); PG8_BAR; PG8_WAIT_L(0); PG8_MMA(0, 0, At, B0); PG8_BAR; PG8_SCHED;
            PG8_LDB(B1, 1, 1); PG8_STAGE(PG8_SB(1, 0), b3, voffB);
            PG8_BAR; PG8_WAIT_L(0); PG8_MMA(0, 1, At, B1); PG8_BAR;
            PG8_LDA(At, 1, 1); PG8_STAGE(PG8_SA(1, 0), a3, voffA);
            PG8_BAR; PG8_WAIT_L(0); PG8_MMA(1, 0, At, B0); PG8_BAR; PG8_SCHED;
            PG8_STAGE(PG8_SB(1, 1), b3 + hstep, voffB);
            PG8_WAIT_V(6); PG8_BAR; PG8_MMA(1, 1, At, B1); PG8_BAR;
            }
        }
        if constexpr (ALIGN_EPI) { if (wr == 0) PG8_BAR; }
        if constexpr (!Epi::AFTER_DRAIN) { E(acc, cur, wr, wc, fr, fq); S.done(cur); }
        if (!has_next) break;
#pragma unroll
        for (int a = 0; a < 2; ++a)
#pragma unroll
            for (int b = 0; b < 2; ++b)
#pragma unroll
                for (int m = 0; m < 4; ++m)
#pragma unroll
                    for (int n = 0; n < 2; ++n) acc[a][b][m][n] = (f32x4){0.f, 0.f, 0.f, 0.f};
        cur = nxt; cA = nA; cB = nB; ++ui;
        if constexpr (ALIGN_EPI) { if (wr == 1) PG8_BAR; }
    }
    PG8_WAIT_V(0);
    if constexpr (!ALIGN_EPI) { if (wr == 0) PG8_BAR; }
    PG8_BAR;
    if constexpr (Epi::AFTER_DRAIN) { E.fused(acc, cur, wr, wc, fr, fq, lds, wid, lane); S.done(cur); }
#undef PG8_SA
#undef PG8_SB
#undef PG8_STAGE
#undef PG8_LDA
#undef PG8_LDB
#undef PG8_MMA
#undef PG8_WAIT_V
#undef PG8_WAIT_L
#undef PG8_BAR
#undef PG8_SCHED
}
}

namespace da {
using bf16 = unsigned short;
using bf16x8 = __attribute__((ext_vector_type(8))) short;
using s16x4  = __attribute__((ext_vector_type(4))) short;
using f32x16 = __attribute__((ext_vector_type(16))) float;
using f32x4  = __attribute__((ext_vector_type(4))) float;
using u32x4  = __attribute__((ext_vector_type(4))) unsigned;
constexpr float SCALE = 0.125f;
constexpr float THR = 8.f;
constexpr int KVBLK = 64, NT = (SEQ + CTX) / KVBLK;
constexpr int SHM_V = 16384, SHM_K = 16384, LDS_VOFF = 0, LDS_KOFF = 32768, LDS_WSOFF = 69632, XSTRIDE = 132;
#define KSWZ(row, colB) ((row) * 256 + ((colB) ^ (((row) & 7) << 4)))
#define SBAR() __builtin_amdgcn_sched_barrier(0)
__device__ __forceinline__ int crow(int r, int hi) { return (r & 3) + 8 * (r >> 2) + 4 * hi; }
__device__ __forceinline__ unsigned cvtpk(float lo, float hi) { unsigned r; asm volatile("v_cvt_pk_bf16_f32 %0, %1, %2" : "=v"(r) : "v"(lo), "v"(hi)); return r; }
__device__ __forceinline__ void partialSM(f32x16& p0, f32x16& p1, float& m_reg, float& mn, float& alpha) {
  constexpr float C = SCALE * 1.4426950408889634f;
  float pmax = p0[0];
#pragma unroll
  for (int r = 1; r < 16; ++r) pmax = fmaxf(pmax, p0[r]);
#pragma unroll
  for (int r = 0; r < 16; ++r) pmax = fmaxf(pmax, p1[r]);
  { auto rr = __builtin_amdgcn_permlane32_swap(__float_as_uint(pmax), __float_as_uint(pmax), false, false);
    pmax = fmaxf(__uint_as_float(rr[0]), __uint_as_float(rr[1])); }
  if (__builtin_expect(__all(pmax - m_reg <= THR / SCALE), 1)) { mn = m_reg; alpha = 1.f; }
  else { mn = fmaxf(m_reg, pmax); alpha = __builtin_amdgcn_exp2f((m_reg - mn) * C); m_reg = mn; }
  float mnC = -mn * C;
#pragma unroll
  for (int r = 0; r < 16; ++r) p0[r] = fmaf(p0[r], C, mnC);
#pragma unroll
  for (int r = 0; r < 16; ++r) p1[r] = fmaf(p1[r], C, mnC);
#pragma unroll
  for (int r = 0; r < 16; ++r) p0[r] = __builtin_amdgcn_exp2f(p0[r]);
}
__device__ __forceinline__ void finishSM(f32x16& p0, f32x16& p1, float alpha, float& l_reg, bf16x8& pa0, bf16x8& pa1, bf16x8& pa2, bf16x8& pa3) {
#pragma unroll
  for (int r = 0; r < 16; ++r) p1[r] = __builtin_amdgcn_exp2f(p1[r]);
  float ps = 0;
#pragma unroll
  for (int r = 0; r < 16; ++r) ps += p0[r];
#pragma unroll
  for (int r = 0; r < 16; ++r) ps += p1[r];
  { auto rr = __builtin_amdgcn_permlane32_swap(__float_as_uint(ps), __float_as_uint(ps), false, false);
    ps = __uint_as_float(rr[0]) + __uint_as_float(rr[1]); }
  l_reg = l_reg * alpha + ps;
#define PK4(P, BASE, OUT) do { unsigned a0 = cvtpk(P[BASE + 0], P[BASE + 1]), a1 = cvtpk(P[BASE + 2], P[BASE + 3]);   \
    unsigned b0 = cvtpk(P[BASE + 4], P[BASE + 5]), b1 = cvtpk(P[BASE + 6], P[BASE + 7]);                              \
    auto r0 = __builtin_amdgcn_permlane32_swap(a0, b0, false, false); auto r1 = __builtin_amdgcn_permlane32_swap(a1, b1, false, false); \
    u32x4 w = {r0[0], r1[0], r0[1], r1[1]}; OUT = *reinterpret_cast<bf16x8*>(&w); } while (0)
  PK4(p0, 0, pa0); PK4(p0, 8, pa1); PK4(p1, 0, pa2); PK4(p1, 8, pa3);
#undef PK4
}
__device__ __forceinline__ void qkt(f32x16& p0, f32x16& p1, const bf16* Ks, const bf16x8* qr, int r32, int hi, int cb0) {
  p0 = f32x16{}; p1 = f32x16{};
#pragma unroll
  for (int d0 = 0; d0 < 4; ++d0) { int cb = (cb0 + d0 * 16 + hi * 8) * 2;
    bf16x8 b0 = *reinterpret_cast<const bf16x8*>((const char*)Ks + KSWZ(r32, cb));
    bf16x8 b1 = *reinterpret_cast<const bf16x8*>((const char*)Ks + KSWZ(32 + r32, cb));
    p0 = __builtin_amdgcn_mfma_f32_32x32x16_bf16(b0, qr[d0], p0, 0, 0, 0);
    p1 = __builtin_amdgcn_mfma_f32_32x32x16_bf16(b1, qr[d0], p1, 0, 0, 0); }
}
__device__ __forceinline__ int v_st(int k, int c) { const int kk = (k & ~0xC) | ((k & 4) << 1) | ((k & 8) >> 1); return ((kk >> 3) * 4 + (c >> 5)) * 512 + ((kk & 7) * 32 + (c & 31)) * 2; }
__device__ __forceinline__ int v_rd_base(int lane) { return ((lane & 3) << 3) | (((lane >> 2) & 3) << 6) | (((lane >> 4) & 1) << 5) | (((lane >> 5) & 1) << 8); }
constexpr int v_rd_off(int d0, int ks, int half) { return d0 * 512 + ks * 4096 + half * 2048; }
template <int OFF> __device__ __forceinline__ s16x4 tr_read(int vb) {
  s16x4 r; asm volatile("ds_read_b64_tr_b16 %0, %1 offset:%2" : "=&v"(r) : "v"(vb), "i"(OFF) : "memory"); return r;
}
template <int D0> __device__ __forceinline__ void pv_one(f32x16& od, int vb, bf16x8 pa0, bf16x8 pa1, bf16x8 pa2, bf16x8 pa3) {
  const s16x4 l0 = tr_read<v_rd_off(D0, 0, 0)>(vb), h0 = tr_read<v_rd_off(D0, 0, 1)>(vb), l1 = tr_read<v_rd_off(D0, 1, 0)>(vb), h1 = tr_read<v_rd_off(D0, 1, 1)>(vb);
  const s16x4 l2 = tr_read<v_rd_off(D0, 2, 0)>(vb), h2 = tr_read<v_rd_off(D0, 2, 1)>(vb), l3 = tr_read<v_rd_off(D0, 3, 0)>(vb), h3 = tr_read<v_rd_off(D0, 3, 1)>(vb);
  asm volatile("s_waitcnt lgkmcnt(0)" ::: "memory"); SBAR();
#define PK(L, H) (bf16x8){L[0], L[1], L[2], L[3], H[0], H[1], H[2], H[3]}
  od = __builtin_amdgcn_mfma_f32_32x32x16_bf16(pa0, PK(l0, h0), od, 0, 0, 0);
  od = __builtin_amdgcn_mfma_f32_32x32x16_bf16(pa1, PK(l1, h1), od, 0, 0, 0);
  od = __builtin_amdgcn_mfma_f32_32x32x16_bf16(pa2, PK(l2, h2), od, 0, 0, 0);
  od = __builtin_amdgcn_mfma_f32_32x32x16_bf16(pa3, PK(l3, h3), od, 0, 0, 0);
#undef PK
}
__device__ __forceinline__ void pv_d0(f32x16* o, int vb, bf16x8 pa0, bf16x8 pa1, bf16x8 pa2, bf16x8 pa3) {
  pv_one<0>(o[0], vb, pa0, pa1, pa2, pa3); pv_one<1>(o[1], vb, pa0, pa1, pa2, pa3); pv_one<2>(o[2], vb, pa0, pa1, pa2, pa3); pv_one<3>(o[3], vb, pa0, pa1, pa2, pa3);
}
__device__ __forceinline__ size_t tile_row(int b, int j) { return (j < SEQ / KVBLK) ? (size_t)b * SEQ + (size_t)j * KVBLK : (size_t)ML + (size_t)b * CTX + (size_t)(j - SEQ / KVBLK) * KVBLK; }

__device__ __forceinline__ void attn_unit(char* lds, const bf16* __restrict__ QD, const bf16* __restrict__ KD, const bf16* __restrict__ VD, bf16* __restrict__ MIXED,
                                          const float* __restrict__ da_w, int b, int h, int qb, float lam) {
  int tid_ = threadIdx.x; asm volatile("" : "+v"(tid_));
  const int tid = tid_, wid = __builtin_amdgcn_readfirstlane(tid >> 6), lane = tid & 63, r32 = lane & 31, hi = lane >> 5;
  const int mp = wid >> 2, wq = wid & 3;
  bf16* V_lds = (bf16*)(lds + LDS_VOFF); bf16* K_lds = (bf16*)(lds + LDS_KOFF);
  float* ws = (float*)(lds + LDS_WSOFF) + wid * 64; float* li_l = ws; float* al_l = ws + 32;
  float m_reg = -1e30f, l_reg = 0; f32x16 o[4] = {}; bf16x8 qr[4];
  const bf16* Qw = QD + ((size_t)b * SEQ + qb * 128 + wq * 32 + r32) * GW + h * HD + mp * 64 + hi * 8;
#pragma unroll
  for (int d0 = 0; d0 < 4; ++d0) qr[d0] = *reinterpret_cast<const bf16x8*>(Qw + d0 * 16);
  const bf16* Kh = KD + h * HD; const bf16* Vh = VD + h * HD;
  const int sr = tid >> 4, sc = (tid & 15) * 8, vst0 = v_st(sr, sc), vst1 = v_st(32 + sr, sc);
  const int vb0 = (int)(uintptr_t)V_lds + v_rd_base(lane);
  const int cb0 = mp * 64;
  struct { bf16x8 vs0, vs1, ks0, ks1; } sr_[2];
#define SLOAD(i, j) do { const size_t kr_ = tile_row(b, (j)); \
    sr_[i].vs0 = *reinterpret_cast<const bf16x8*>(&Vh[(kr_ + sr) * GW + sc]); sr_[i].vs1 = *reinterpret_cast<const bf16x8*>(&Vh[(kr_ + 32 + sr) * GW + sc]); \
    sr_[i].ks0 = *reinterpret_cast<const bf16x8*>(&Kh[(kr_ + sr) * GW + sc]); sr_[i].ks1 = *reinterpret_cast<const bf16x8*>(&Kh[(kr_ + 32 + sr) * GW + sc]); } while (0)
#define SWRITE(bb, i) do { *(bf16x8*)((char*)V_lds + (bb) * SHM_V + vst0) = sr_[i].vs0;          \
    *(bf16x8*)((char*)V_lds + (bb) * SHM_V + vst1) = sr_[i].vs1; int kc = sc * 2;               \
    *(bf16x8*)((char*)K_lds + (bb) * SHM_K + KSWZ(sr, kc)) = sr_[i].ks0;                       \
    *(bf16x8*)((char*)K_lds + (bb) * SHM_K + KSWZ(32 + sr, kc)) = sr_[i].ks1; } while (0)
#define SWAIT() asm volatile("s_waitcnt vmcnt(4)" ::: "memory")
#define RESC(a) do { if (__any((a) < 1.f)) { if (hi == 0) al_l[r32] = (a); asm volatile("s_waitcnt lgkmcnt(0)" ::: "memory"); \
    _Pragma("unroll") for (int d = 0; d < 4; ++d) _Pragma("unroll") for (int r = 0; r < 16; ++r) o[d][r] *= al_l[crow(r, hi)]; } } while (0)
  f32x16 pA0, pA1, pB0, pB1; float mnA, mnB, alA, alB; bf16x8 pa0, pa1, pa2, pa3;
  constexpr int SE = 0, SO = 1;
  SLOAD(SE, 0); asm volatile("s_waitcnt vmcnt(0)" ::: "memory"); SWRITE(0, SE); __syncthreads();
  qkt(pA0, pA1, K_lds, qr, r32, hi, cb0); partialSM(pA0, pA1, m_reg, mnA, alA);
  SLOAD(SO, 1); SLOAD(SE, 2);
  SWAIT(); SWRITE(1, SO); __syncthreads();
  for (int j = 1; j + 1 < NT; j += 2) {
    SBAR(); qkt(pB0, pB1, (bf16*)((char*)K_lds + SHM_K), qr, r32, hi, cb0);
    finishSM(pA0, pA1, alA, l_reg, pa0, pa1, pa2, pa3); SBAR();
    SLOAD(SO, j + 2); SBAR();
    pv_d0(o, vb0, pa0, pa1, pa2, pa3); partialSM(pB0, pB1, m_reg, mnB, alB);
    __syncthreads(); SWAIT(); SWRITE(0, SE);
    RESC(alB); __syncthreads();
    SBAR(); qkt(pA0, pA1, K_lds, qr, r32, hi, cb0);
    finishSM(pB0, pB1, alB, l_reg, pa0, pa1, pa2, pa3); SBAR();
    if (j + 3 < NT) SLOAD(SE, j + 3); SBAR();
    pv_d0(o, vb0 + SHM_V, pa0, pa1, pa2, pa3); partialSM(pA0, pA1, m_reg, mnA, alA);
    __syncthreads(); SWAIT(); SWRITE(1, SO);
    RESC(alA); __syncthreads();
  }
  SBAR(); qkt(pB0, pB1, (bf16*)((char*)K_lds + SHM_K), qr, r32, hi, cb0);
  finishSM(pA0, pA1, alA, l_reg, pa0, pa1, pa2, pa3); SBAR();
  pv_d0(o, vb0, pa0, pa1, pa2, pa3); partialSM(pB0, pB1, m_reg, mnB, alB);
  __syncthreads(); RESC(alB);
  finishSM(pB0, pB1, alB, l_reg, pa0, pa1, pa2, pa3); SBAR();
  pv_d0(o, vb0 + SHM_V, pa0, pa1, pa2, pa3);
  if (hi == 0) li_l[r32] = l_reg; asm volatile("s_waitcnt lgkmcnt(0)" ::: "memory");
  float rli[16];
  const float fac = mp ? lam : 1.f;
#pragma unroll
  for (int r = 0; r < 16; ++r) rli[r] = __builtin_amdgcn_rcpf(li_l[crow(r, hi)]) * fac;
  __syncthreads();
  float* X = (float*)lds;
  if (mp == 1) {
#pragma unroll
    for (int r = 0; r < 16; ++r)
#pragma unroll
      for (int d0 = 0; d0 < 4; ++d0) X[(wq * 32 + crow(r, hi)) * XSTRIDE + d0 * 32 + r32] = o[d0][r] * rli[r];
  }
  __syncthreads();
  if (mp == 0) {
#pragma unroll
    for (int r = 0; r < 16; ++r)
#pragma unroll
      for (int d0 = 0; d0 < 4; ++d0) { float* p = &X[(wq * 32 + crow(r, hi)) * XSTRIDE + d0 * 32 + r32]; *p = o[d0][r] * rli[r] - *p; }
  }
  __syncthreads();
  { const int row = tid >> 2, q4 = tid & 3;
    const float* xr = X + row * XSTRIDE + q4 * 32;
    f32x4 v[8]; float ss = 0.f;
#pragma unroll
    for (int i = 0; i < 8; ++i) { v[i] = *(const f32x4*)(xr + 4 * i); ss += (v[i][0] * v[i][0] + v[i][1] * v[i][1]) + (v[i][2] * v[i][2] + v[i][3] * v[i][3]); }
    ss += __shfl_xor(ss, 1); ss += __shfl_xor(ss, 2);
    const float rs = ONE_M_LAMINIT / sqrtf(ss * (1.f / 128.f) + LN_EPS);
    bf16* op = MIXED + ((size_t)b * SEQ + qb * 128 + row) * DM + h * HD + q4 * 32;
#pragma unroll
    for (int i = 0; i < 4; ++i) { const f32x4 w0 = *(const f32x4*)(da_w + q4 * 32 + 8 * i), w1 = *(const f32x4*)(da_w + q4 * 32 + 8 * i + 4);
      const f32x4 a = v[2 * i] * w0 * rs, c = v[2 * i + 1] * w1 * rs;
      u32x4 w; w.x = cvtpk(a[0], a[1]); w.y = cvtpk(a[2], a[3]); w.z = cvtpk(c[0], c[1]); w.w = cvtpk(c[2], c[3]);
      *(u32x4*)(op + 8 * i) = w; } }
  __syncthreads();
#undef SLOAD
#undef SWRITE
#undef SWAIT
#undef RESC
}
#undef KSWZ
#undef SBAR
}

constexpr int NWAVES = 8;
constexpr size_t MiB = 1u << 20;
constexpr size_t WS_CTL = 0, CTL_ZERO_BYTES = 1 * MiB;
constexpr size_t WS_SMALL = 1 * MiB;
constexpr size_t SM_ADA = 0, SM_ROPE = 448 * 1024, SM_LBF = 464 * 1024, SM_LBB = 468 * 1024;
constexpr size_t WS_WOUT = 2 * MiB, WS_WFF1 = 10 * MiB, WS_WFF2 = 42 * MiB, WS_WIN = 74 * MiB;
constexpr size_t WS_XM = 106 * MiB;
constexpr size_t WS_P = 178 * MiB;
constexpr size_t WS_U = 178 * MiB, WS_H = 242 * MiB, WS_END = 498 * MiB;
static_assert(WS_P + 8 * GSTRIDE * 2 <= WS_END && WS_H + (size_t)ML * DFF * 2 <= WS_END && WS_U + (size_t)ML * DM * 2 <= WS_H && WS_XM + (size_t)MT * DM * 2 <= WS_P, "d_ws map");
static_assert(9 * NADA * 4 <= SM_ROPE && SM_ROPE + 64 * 16 * 8 <= SM_LBF, "small map");
constexpr int CW_TMO = 0, CW_CODE = 1, CW_BAR = 4096, CW_Q = 16384, CW_TS = 20480;

constexpr int LDS_BYTES = 147456;
constexpr int LDSCTL_OFF = LDS_BYTES - 512;

#define GAS __attribute__((address_space(1)))
#define LAS __attribute__((address_space(3)))
typedef unsigned short bf16;
typedef unsigned v4u __attribute__((ext_vector_type(4)));
typedef unsigned v2u __attribute__((ext_vector_type(2)));
typedef float f32x4 __attribute__((ext_vector_type(4)));
typedef GAS unsigned gu32;
#define RLX_AGENT __ATOMIC_RELAXED, __HIP_MEMORY_SCOPE_AGENT
#define LDS_WAIT() asm volatile("s_waitcnt lgkmcnt(0)" ::: "memory")
#define VM_WAIT() asm volatile("s_waitcnt vmcnt(0)" ::: "memory")
__device__ __forceinline__ unsigned f2bf(float f) { unsigned u = __builtin_bit_cast(unsigned, f); return (u + 0x7fffu + ((u >> 16) & 1u)) >> 16; }
__device__ __forceinline__ unsigned pk2(float lo, float hi) { return f2bf(lo) | (f2bf(hi) << 16); }
__device__ __forceinline__ float bf_lo(unsigned w) { return __uint_as_float(w << 16); }
__device__ __forceinline__ float bf_hi(unsigned w) { return __uint_as_float(w & 0xffff0000u); }

#define XB_TMO      128
#define XB_XCNT(j)  (256  + 64 * (j))
#define XB_XSUB(j)  (1280 + 64 * (j))
#define XB_XGEN(j)  (2304 + 64 * (j))
#define XB_TOP      3328
#define XB_TOPGEN   3392
#define XCD_BAR_WORDS 3456
#define XB_SPIN_CAP (1u << 18)

__device__ __forceinline__ unsigned xb_ld(unsigned* p)              { return __hip_atomic_load(p, __ATOMIC_RELAXED, __HIP_MEMORY_SCOPE_AGENT); }
__device__ __forceinline__ unsigned xb_add(unsigned* p, unsigned v) { return __hip_atomic_fetch_add(p, v, __ATOMIC_RELAXED, __HIP_MEMORY_SCOPE_AGENT); }
__device__ __forceinline__ unsigned xb_xcc_id() { return (unsigned)__builtin_amdgcn_s_getreg((3 << 11) | 20) & 0xFu; }
#define XB_SPIN(cond, bar) do { unsigned _sp = 0; while (cond) { __builtin_amdgcn_s_sleep(1); \
    if ((++_sp & 255u) == 0u) { if (xb_ld(&(bar)[XB_TMO])) break; if (_sp > XB_SPIN_CAP) { atomicAdd(&(bar)[XB_TMO], 1u); break; } } } } while (0)

struct XcdBarrier {
    unsigned* bar; unsigned x;
    volatile LAS unsigned* st;
};

__device__ __forceinline__ XcdBarrier xcd_barrier_post(unsigned* bar, volatile LAS unsigned* st) {
    XcdBarrier b; b.bar = bar; b.x = xb_xcc_id(); b.st = st;
    if (threadIdx.x == 0) (void)xb_add(&bar[XB_XCNT(b.x)], 1u);
    return b;
}
__device__ __forceinline__ void xcd_barrier_complete(unsigned* bar, unsigned x, unsigned& nloc, unsigned& nx) {
    const unsigned G = gridDim.x * gridDim.y * gridDim.z;
    unsigned sum, cnt, mine, sp = 0u;
    for (;;) {
        sum = 0u; cnt = 0u; mine = 0u;
#pragma unroll
        for (unsigned j = 0; j < 16; ++j) { const unsigned c = xb_ld(&bar[XB_XCNT(j)]); sum += c; cnt += (c > 0u) ? 1u : 0u; mine = (j == x) ? c : mine; }
        if (sum == G) break;
        __builtin_amdgcn_s_sleep(1);
        if ((++sp & 255u) == 0u) { if (xb_ld(&bar[XB_TMO])) break; if (sp > XB_SPIN_CAP) { atomicAdd(&bar[XB_TMO], 1u); break; } }
    }
    nloc = mine > 0u ? mine : 1u; nx = cnt > 0u ? cnt : 1u;
}

__device__ __forceinline__ void xcd_barrier(const XcdBarrier& b) {
    asm volatile("s_waitcnt vmcnt(0)" ::: "memory");
    __syncthreads();
    if (threadIdx.x == 0) {
        unsigned* bar = b.bar;
        __builtin_amdgcn_s_waitcnt(0);
        unsigned nloc = b.st[0], nx = b.st[1];
        if (nloc == 0u) { xcd_barrier_complete(bar, b.x, nloc, nx); b.st[0] = nloc; b.st[1] = nx; }
        const unsigned old = xb_add(&bar[XB_XSUB(b.x)], 1u);
        const unsigned gen = old / nloc;
        if (old + 1u == (gen + 1u) * nloc) {
            __builtin_amdgcn_fence(__ATOMIC_RELEASE, "agent");
            asm volatile("s_waitcnt vmcnt(0)" ::: "memory");
            const unsigned og = xb_add(&bar[XB_TOP], 1u);
            const unsigned tg = og / nx;
            if (og + 1u == (tg + 1u) * nx) xb_add(&bar[XB_TOPGEN], 1u);
            else XB_SPIN(xb_ld(&bar[XB_TOPGEN]) == tg, bar);
            __builtin_amdgcn_fence(__ATOMIC_ACQUIRE, "agent");
            xb_add(&bar[XB_XGEN(b.x)], 1u);
            asm volatile("s_waitcnt vmcnt(0)" ::: "memory");
        } else {
            XB_SPIN(xb_ld(&bar[XB_XGEN(b.x)]) == gen, bar);
            __builtin_amdgcn_fence(__ATOMIC_ACQUIRE, "agent");
            asm volatile("s_waitcnt vmcnt(0)" ::: "memory");
        }
    }
    __syncthreads();
}

struct Frame {
    LAS unsigned char* lds;
    volatile LAS unsigned* MISC;
    gu32* ctl;
    int vcu, G;
    const float* in[22];
    float* out;
    unsigned char* ws;
};
__device__ __forceinline__ int opaque_tid() { int t = threadIdx.x; asm volatile("" : "+v"(t)); return t; }
__device__ __forceinline__ float wave_sum(float v) {
#pragma unroll
    for (int o = 1; o < 64; o <<= 1) v += __shfl_xor(v, o);
    return v;
}
__device__ __forceinline__ void p0_transpose_item(const float* W, int K, int N, bf16* WT, LAS float* scr, int item, int lane) {
    const int nblk = N / 32, kb = item / nblk, nb = item % nblk, k0 = 64 * kb, n0 = 32 * nb;
#pragma unroll 8
    for (int i = 0; i < 32; ++i) { const int kk = 2 * i + (lane >> 5); scr[kk * 33 + (lane & 31)] = W[(size_t)(k0 + kk) * N + n0 + (lane & 31)]; }
    LDS_WAIT(); asm volatile("" ::: "memory");
    const int c = lane & 7;
#pragma unroll
    for (int j = 0; j < 4; ++j) { const int n = (lane >> 3) + 8 * j; const LAS float* s = scr + (8 * c) * 33 + n;
        v4u o; o.x = pk2(s[0 * 33], s[1 * 33]); o.y = pk2(s[2 * 33], s[3 * 33]); o.z = pk2(s[4 * 33], s[5 * 33]); o.w = pk2(s[6 * 33], s[7 * 33]);
        *(GAS v4u*)(WT + (size_t)(n0 + n) * K + k0 + 8 * c) = o; }
    LDS_WAIT(); asm volatile("" ::: "memory");
}

__device__ __forceinline__ void p0_prologue(Frame& F) {
    const int tid = opaque_tid(), lane = tid & 63, wave = __builtin_amdgcn_readfirstlane(tid >> 6); (void)lane; (void)wave;
    const float* c = F.in[1]; const float* c_ctx = F.in[3]; const float* w_ada = F.in[4]; const float* b_ada = F.in[5];
    float* M_ADA = (float*)(F.ws + WS_SMALL + SM_ADA);
    { const int gt = F.vcu * (NWAVES * 64) + tid;
      if (gt < 1024) { const int pos = gt >> 4, i = gt & 15;
          const float inv = __builtin_amdgcn_exp2f(-(float)i * (13.287712379549449f / 16.f));
          const float rev = (float)pos * inv * 0.15915494309189535f;
          float* rp = (float*)(F.ws + WS_SMALL + SM_ROPE) + 2 * gt; rp[0] = __builtin_amdgcn_cosf(rev); rp[1] = __builtin_amdgcn_sinf(rev); }
      else if (gt < 3072) { const int k = gt - 1024, which = k >> 10, ch = k & 1023; const float* src = which ? F.in[13] : F.in[12];
          const float a0 = src[ch], a1 = src[1024 + ch];
          ((float*)(F.ws + WS_SMALL + (which ? SM_LBB : SM_LBF)))[ch] = 1.f / (1.f + expf(a1 - a0)); } }
    LAS float* scond = (LAS float*)F.lds;
    for (int i = tid; i < 9 * DM; i += NWAVES * 64) { const int r = i >> 11, k = i & (DM - 1); const float cv = (r < 8) ? c[r * DM + k] : c_ctx[k]; scond[i] = cv / (1.f + expf(-cv)); }
    __syncthreads();
    LAS float* red = (LAS float*)(F.lds + 9 * DM * 4);
    for (int item = F.vcu; item < NADA / 32; item += F.G) {
        const int c0 = item * 32, kr = lane >> 3, cq = (lane & 7) * 4;
        float acc[9][4];
#pragma unroll
        for (int r = 0; r < 9; ++r) { acc[r][0] = 0.f; acc[r][1] = 0.f; acc[r][2] = 0.f; acc[r][3] = 0.f; }
#pragma unroll 4
        for (int it = 0; it < 32; ++it) {
            const int k = it * 64 + wave * 8 + kr;
            const f32x4 w = *(const GAS f32x4*)(w_ada + (size_t)k * NADA + c0 + cq);
#pragma unroll
            for (int r = 0; r < 9; ++r) { const float s = scond[r * DM + k]; acc[r][0] += s * w[0]; acc[r][1] += s * w[1]; acc[r][2] += s * w[2]; acc[r][3] += s * w[3]; }
        }
#pragma unroll
        for (int r = 0; r < 9; ++r)
#pragma unroll
            for (int j = 0; j < 4; ++j) { float v = acc[r][j]; v += __shfl_xor(v, 8); v += __shfl_xor(v, 16); v += __shfl_xor(v, 32); acc[r][j] = v; }
        if (lane < 8) {
#pragma unroll
            for (int r = 0; r < 9; ++r)
#pragma unroll
                for (int j = 0; j < 4; ++j) red[(wave * 9 + r) * 32 + cq + j] = acc[r][j]; }
        __syncthreads();
        if (tid < 288) { const int r = tid >> 5, cc = tid & 31; float s = 0.f;
#pragma unroll
            for (int w = 0; w < 8; ++w) s += red[(w * 9 + r) * 32 + cc];
            M_ADA[r * NADA + c0 + cc] = s + b_ada[c0 + cc]; }
        __syncthreads();
    }
    LAS float* scr = (LAS float*)(F.lds + wave * 8448);
    const int gw = F.vcu * NWAVES + wave, NGW = F.G * NWAVES;
    constexpr int I_IN = (DM / 64) * (NIN / 32), I_OUT = (DM / 64) * (DM / 32), I_F1 = (DM / 64) * (DFF / 32), I_F2 = (DFF / 64) * (DM / 32);
    constexpr int NITEMS = I_IN + I_OUT + I_F1 + I_F2;
    for (int it = gw; it < NITEMS; it += NGW) {
        int r = it;
        if (r < I_IN) { p0_transpose_item(F.in[6], DM, NIN, (bf16*)(F.ws + WS_WIN), scr, r, lane); continue; } r -= I_IN;
        if (r < I_OUT) { p0_transpose_item(F.in[15], DM, DM, (bf16*)(F.ws + WS_WOUT), scr, r, lane); continue; } r -= I_OUT;
        if (r < I_F1) { p0_transpose_item(F.in[18], DM, DFF, (bf16*)(F.ws + WS_WFF1), scr, r, lane); continue; } r -= I_F1;
        p0_transpose_item(F.in[19], DFF, DM, (bf16*)(F.ws + WS_WFF2), scr, r, lane);
    }
}

__device__ __forceinline__ void p1_prep(Frame& F) {
    const int tid = opaque_tid(), lane = tid & 63, wave = __builtin_amdgcn_readfirstlane(tid >> 6); (void)lane; (void)wave;
    const float* M_ADA = (const float*)(F.ws + WS_SMALL + SM_ADA);
    bf16* XM = (bf16*)(F.ws + WS_XM);
    const int gw = F.vcu * NWAVES + wave, NGW = F.G * NWAVES;
    for (int row = gw; row < MT; row += NGW) {
        const float* src; int mr;
        if (row < ML) { src = F.in[0] + (size_t)row * DM; mr = row >> 11; } else { src = F.in[2] + (size_t)(row - ML) * DM; mr = 8; }
        const float* sh = M_ADA + (size_t)mr * NADA; const float* sc = sh + DM;
        GAS v2u* o8 = (GAS v2u*)(XM + (size_t)row * DM) + lane;
#pragma unroll
        for (int j = 0; j < 8; ++j) { const int col = 4 * lane + 256 * j;
            const f32x4 xv = *(const GAS f32x4*)(src + col), s1 = *(const GAS f32x4*)(sc + col), s0 = *(const GAS f32x4*)(sh + col);
            const f32x4 y = xv * (s1 + 1.f) + s0;
            v2u w; w.x = pk2(y[0], y[1]); w.y = pk2(y[2], y[3]); o8[64 * j] = w; }
    }
}

#if 0
__device__ __forceinline__ void hgrn_unit_seq(Frame& F, const bf16* QH, const bf16* LFG, const bf16* IH, float* OUT, int b, int h, int dir) {
    const int tid = opaque_tid(), lane = tid & 63, wave = __builtin_amdgcn_readfirstlane(tid >> 6); (void)lane; (void)wave;
    LAS float* qs = (LAS float*)F.lds; LAS float* fs = qs + 16 * 128; LAS float* ks = fs + 16 * 128; LAS float* vs = ks + 16 * 128; LAS float* opart = vs + 16 * 128;
    const int v = tid & 127, dq = tid >> 7, tk_l = tid >> 5, ch4 = (tid & 31) * 4;
    float S[32];
#pragma unroll
    for (int i = 0; i < 32; ++i) S[i] = 0.f;
    for (int n0 = 0; n0 < CTX + SEQ; n0 += 16) {
        { const int n = n0 + tk_l; size_t row;
          if (n < CTX) row = (size_t)ML + (size_t)b * CTX + (dir ? CTX - 1 - n : n); else { const int tl = n - CTX; row = (size_t)b * SEQ + (dir ? SEQ - 1 - tl : tl); }
          const size_t off = row * GW + h * HD + ch4;
          const v2u qw = *(const GAS v2u*)(QH + off), lw = *(const GAS v2u*)(LFG + off), vw = *(const GAS v2u*)(IH + off);
          const f32x4 qv = {bf_lo(qw.x), bf_hi(qw.x), bf_lo(qw.y), bf_hi(qw.y)}, lv = {bf_lo(lw.x), bf_hi(lw.x), bf_lo(lw.y), bf_hi(lw.y)}, vv = {bf_lo(vw.x), bf_hi(vw.x), bf_lo(vw.y), bf_hi(vw.y)};
          f32x4 fv, kv;
#pragma unroll
          for (int j = 0; j < 4; ++j) { fv[j] = expf(lv[j]); kv[j] = -expm1f(lv[j]); }
          *(LAS f32x4*)(qs + tk_l * 128 + ch4) = qv; *(LAS f32x4*)(fs + tk_l * 128 + ch4) = fv; *(LAS f32x4*)(ks + tk_l * 128 + ch4) = kv; *(LAS f32x4*)(vs + tk_l * 128 + ch4) = vv; }
        __syncthreads();
#pragma unroll 2
        for (int tk = 0; tk < 16; ++tk) {
            const float vv = vs[tk * 128 + v]; float op = 0.f;
#pragma unroll
            for (int i = 0; i < 32; i += 4) {
                const f32x4 f4 = *(const LAS f32x4*)(fs + tk * 128 + 32 * dq + i), k4 = *(const LAS f32x4*)(ks + tk * 128 + 32 * dq + i), q4 = *(const LAS f32x4*)(qs + tk * 128 + 32 * dq + i);
#pragma unroll
                for (int j = 0; j < 4; ++j) { S[i + j] = f4[j] * S[i + j] + k4[j] * vv; op += S[i + j] * q4[j]; }
            }
            opart[(tk * 4 + dq) * 128 + v] = op;
        }
        __syncthreads();
        if (n0 >= CTX) { const int tl = n0 + tk_l - CTX; const size_t row = (size_t)b * SEQ + (dir ? SEQ - 1 - tl : tl);
            f32x4 s = *(const LAS f32x4*)(opart + (tk_l * 4 + 0) * 128 + ch4);
#pragma unroll
            for (int d = 1; d < 4; ++d) s = s + *(const LAS f32x4*)(opart + (tk_l * 4 + d) * 128 + ch4);
            *(GAS f32x4*)(OUT + row * GW + h * HD + ch4) = s; }
        __syncthreads();
    }
}


#endif
typedef short hbf16x8 __attribute__((ext_vector_type(8)));
constexpr int HG_RAWQ = 0, HG_RAWL = 16384, HG_RAWV = 32768, HG_QT = 49152, HG_KT = 66560, HG_KTT = 83968, HG_VTT = 102400, HG_AIMG = 120832, HG_SEGT = 130048, HG_BL = 132096;
constexpr int HG_QS = 272, HG_TS = 144;
static_assert(HG_BL + 512 <= LDSCTL_OFF, "hgrn lds map");
__device__ __forceinline__ size_t hg_row(int b, int dir, int c, int j) {
    if (c < 4) { const int n = 64 * c + j; return (size_t)ML + (size_t)b * CTX + (size_t)(dir ? CTX - 1 - n : n); }
    const int n = 64 * (c - 4) + j; return (size_t)b * SEQ + (size_t)(dir ? SEQ - 1 - n : n);
}
__device__ __forceinline__ void hgrn_unit_chunk(LAS unsigned char* L, const bf16* QH, const bf16* LFG, const bf16* IH, float* OUT, int b, int h, int dir) {
    int tid_ = threadIdx.x; asm volatile("" : "+v"(tid_));
    const int tid = tid_, lane = tid & 63, w = __builtin_amdgcn_readfirstlane(tid >> 6), c16 = lane & 15, g = lane >> 4;
    const int d = tid & 127, seg = __builtin_amdgcn_readfirstlane(tid >> 7);
    const int lr = tid >> 4, lc = (tid & 15) * 8;
    f32x4 Sacc[8];
#pragma unroll
    for (int i = 0; i < 8; ++i) Sacc[i] = (f32x4){0.f, 0.f, 0.f, 0.f};
    v4u pq0, pq1, pl0, pl1, pv0, pv1;
#define HG_LOAD(cc) do { const size_t r0_ = hg_row(b, dir, (cc), lr) * GW + h * HD + lc, r1_ = hg_row(b, dir, (cc), lr + 32) * GW + h * HD + lc; \
        pq0 = *(const GAS v4u*)(QH + r0_); pq1 = *(const GAS v4u*)(QH + r1_); pl0 = *(const GAS v4u*)(LFG + r0_); pl1 = *(const GAS v4u*)(LFG + r1_); \
        pv0 = *(const GAS v4u*)(IH + r0_); pv1 = *(const GAS v4u*)(IH + r1_); } while (0)
    HG_LOAD(0);
    for (int c = 0; c < 36; ++c) {
        *(LAS v4u*)(L + HG_RAWQ + lr * 256 + lc * 2) = pq0; *(LAS v4u*)(L + HG_RAWQ + (lr + 32) * 256 + lc * 2) = pq1;
        *(LAS v4u*)(L + HG_RAWL + lr * 256 + lc * 2) = pl0; *(LAS v4u*)(L + HG_RAWL + (lr + 32) * 256 + lc * 2) = pl1;
        *(LAS v4u*)(L + HG_RAWV + lr * 256 + lc * 2) = pv0; *(LAS v4u*)(L + HG_RAWV + (lr + 32) * 256 + lc * 2) = pv1;
        __syncthreads();
        if (c + 1 < 36) HG_LOAD(c + 1);
        float lf[16], cs[16];
        { float run = 0.f;
#pragma unroll
          for (int i = 0; i < 16; ++i) { lf[i] = __uint_as_float((unsigned)*(const LAS unsigned short*)(L + HG_RAWL + (16 * seg + i) * 256 + d * 2) << 16); run += lf[i]; cs[i] = run; }
          *(LAS float*)(L + HG_SEGT + (seg * 128 + d) * 4) = run; }
        __syncthreads();
        { float off = 0.f, tot = 0.f;
#pragma unroll
          for (int s2 = 0; s2 < 4; ++s2) { const float t = *(const LAS float*)(L + HG_SEGT + (s2 * 128 + d) * 4); tot += t; if (s2 < seg) off += t; }
          if (seg == 0) *(LAS float*)(L + HG_BL + d * 4) = __expf(tot);
          unsigned kp[8], vp[8];
#pragma unroll
          for (int i = 0; i < 16; i += 2) {
              const float b0 = off + cs[i], b1 = off + cs[i + 1];
              const float k0 = (1.f - __expf(lf[i])) * __expf(-b0), k1 = (1.f - __expf(lf[i + 1])) * __expf(-b1);
              kp[i >> 1] = pk2(k0, k1);
              const unsigned v0 = *(const LAS unsigned short*)(L + HG_RAWV + (16 * seg + i) * 256 + d * 2), v1 = *(const LAS unsigned short*)(L + HG_RAWV + (16 * seg + i + 1) * 256 + d * 2);
              vp[i >> 1] = v0 | (v1 << 16);
              if (c >= 4) {
                  const float q0 = __uint_as_float((unsigned)*(const LAS unsigned short*)(L + HG_RAWQ + (16 * seg + i) * 256 + d * 2) << 16);
                  const float q1 = __uint_as_float((unsigned)*(const LAS unsigned short*)(L + HG_RAWQ + (16 * seg + i + 1) * 256 + d * 2) << 16);
                  *(LAS unsigned short*)(L + HG_QT + (16 * seg + i) * HG_QS + d * 2) = (unsigned short)f2bf(q0 * __expf(b0));
                  *(LAS unsigned short*)(L + HG_QT + (16 * seg + i + 1) * HG_QS + d * 2) = (unsigned short)f2bf(q1 * __expf(b1));
                  *(LAS unsigned short*)(L + HG_KT + (16 * seg + i) * HG_QS + d * 2) = (unsigned short)(kp[i >> 1] & 0xffffu);
                  *(LAS unsigned short*)(L + HG_KT + (16 * seg + i + 1) * HG_QS + d * 2) = (unsigned short)(kp[i >> 1] >> 16);
              }
          }
          *(LAS v4u*)(L + HG_KTT + d * HG_TS + seg * 32) = (v4u){kp[0], kp[1], kp[2], kp[3]}; *(LAS v4u*)(L + HG_KTT + d * HG_TS + seg * 32 + 16) = (v4u){kp[4], kp[5], kp[6], kp[7]};
          *(LAS v4u*)(L + HG_VTT + d * HG_TS + seg * 32) = (v4u){vp[0], vp[1], vp[2], vp[3]}; *(LAS v4u*)(L + HG_VTT + d * HG_TS + seg * 32 + 16) = (v4u){vp[4], vp[5], vp[6], vp[7]}; }
        __syncthreads();
        hbf16x8 vf[2];
#pragma unroll
        for (int ks = 0; ks < 2; ++ks) vf[ks] = *(const LAS hbf16x8*)(L + HG_VTT + (16 * w + c16) * HG_TS + (32 * ks + 8 * g) * 2);
        f32x4 oacc[4];
#pragma unroll
        for (int mt = 0; mt < 4; ++mt) oacc[mt] = (f32x4){0.f, 0.f, 0.f, 0.f};
        if (c >= 4) {
            const int tb = w >> 1;
#pragma unroll
            for (int q = 0; q < 2; ++q) { const int sb = 2 * (w & 1) + q;
                f32x4 a = (f32x4){0.f, 0.f, 0.f, 0.f};
                if (sb <= tb) {
#pragma unroll
                    for (int ks = 0; ks < 4; ++ks) {
                        const hbf16x8 ka = *(const LAS hbf16x8*)(L + HG_KT + (16 * sb + c16) * HG_QS + (32 * ks + 8 * g) * 2);
                        const hbf16x8 qb = *(const LAS hbf16x8*)(L + HG_QT + (16 * tb + c16) * HG_QS + (32 * ks + 8 * g) * 2);
                        a = __builtin_amdgcn_mfma_f32_16x16x32_bf16(ka, qb, a, 0, 0, 0); }
#pragma unroll
                    for (int r = 0; r < 4; ++r) if (16 * sb + 4 * g + r > 16 * tb + c16) a[r] = 0.f;
                }
                *(LAS v2u*)(L + HG_AIMG + (16 * tb + c16) * HG_TS + (16 * sb + 4 * g) * 2) = (v2u){pk2(a[0], a[1]), pk2(a[2], a[3])};
            }
            hbf16x8 sf[4];
#pragma unroll
            for (int ks = 0; ks < 4; ++ks) { const v4u t = (v4u){pk2(Sacc[2 * ks][0], Sacc[2 * ks][1]), pk2(Sacc[2 * ks][2], Sacc[2 * ks][3]), pk2(Sacc[2 * ks + 1][0], Sacc[2 * ks + 1][1]), pk2(Sacc[2 * ks + 1][2], Sacc[2 * ks + 1][3])};
                sf[ks] = __builtin_bit_cast(hbf16x8, t); }
#pragma unroll
            for (int mt = 0; mt < 4; ++mt)
#pragma unroll
                for (int ks = 0; ks < 4; ++ks) {
                    const v2u lo = *(const LAS v2u*)(L + HG_QT + (16 * mt + c16) * HG_QS + (32 * ks + 4 * g) * 2), hi = *(const LAS v2u*)(L + HG_QT + (16 * mt + c16) * HG_QS + (32 * ks + 16 + 4 * g) * 2);
                    const v4u t = (v4u){lo.x, lo.y, hi.x, hi.y};
                    oacc[mt] = __builtin_amdgcn_mfma_f32_16x16x32_bf16(__builtin_bit_cast(hbf16x8, t), sf[ks], oacc[mt], 0, 0, 0); }
        }
#pragma unroll
        for (int i = 0; i < 8; ++i)
#pragma unroll
            for (int ks = 0; ks < 2; ++ks) {
                const hbf16x8 ka = *(const LAS hbf16x8*)(L + HG_KTT + (16 * i + c16) * HG_TS + (32 * ks + 8 * g) * 2);
                Sacc[i] = __builtin_amdgcn_mfma_f32_16x16x32_bf16(ka, vf[ks], Sacc[i], 0, 0, 0); }
#pragma unroll
        for (int i = 0; i < 8; ++i) { const f32x4 bl = *(const LAS f32x4*)(L + HG_BL + (16 * i + 4 * g) * 4); Sacc[i] = Sacc[i] * bl; }
        __syncthreads();
        if (c >= 4) {
#pragma unroll
            for (int mt = 0; mt < 4; ++mt)
#pragma unroll
                for (int ks = 0; ks < 2; ++ks) {
                    const hbf16x8 aa = *(const LAS hbf16x8*)(L + HG_AIMG + (16 * mt + c16) * HG_TS + (32 * ks + 8 * g) * 2);
                    oacc[mt] = __builtin_amdgcn_mfma_f32_16x16x32_bf16(aa, vf[ks], oacc[mt], 0, 0, 0); }
#pragma unroll
            for (int mt = 0; mt < 4; ++mt)
#pragma unroll
                for (int r = 0; r < 4; ++r) OUT[hg_row(b, dir, c, 16 * mt + 4 * g + r) * GW + h * HD + 16 * w + c16] = oacc[mt][r];
        }
    }
#undef HG_LOAD
}

__device__ __forceinline__ void p3_mixer(Frame& F, unsigned char* lds_generic, unsigned myx) {
    const int tid = opaque_tid(), lane = tid & 63, wave = __builtin_amdgcn_readfirstlane(tid >> 6); (void)lane; (void)wave;
    const bf16* P = (const bf16*)(F.ws + WS_P);
    bf16* MIXED = (bf16*)(F.ws + WS_XM);
    float lam;
    { const float a = (lane < 64) ? F.in[7][lane] * F.in[8][lane] : 0.f, c2 = F.in[9][lane] * F.in[10][lane];
      lam = expf(wave_sum(a)) - expf(wave_sum(c2)) + LAM_INIT; }
    for (;;) {
        __syncthreads();
        if (tid == 0) { int code = -1;
            for (int k = 0; k < 8; ++k) { const unsigned x = (myx + (unsigned)k) & 7u; const unsigned n = __hip_atomic_fetch_add(F.ctl + CW_Q + 64 * x, 1u, RLX_AGENT); if (n < 144u) { code = (int)(x * 144u + n); break; } }
            F.MISC[4] = (unsigned)code; }
        __syncthreads();
        const int code = (int)F.MISC[4];
        if (code < 0) break;
        const int x = code / 144, n = code % 144;
        if (n < 16) { const int u = x + 8 * n, bh = u >> 1, dir = u & 1;
            hgrn_unit_chunk(F.lds, P + G_QH * GSTRIDE, P + (dir ? G_ZB : G_ZF) * GSTRIDE, P + G_IH * GSTRIDE, F.out + (size_t)dir * ML * GW, bh >> 3, bh & 7, dir);
        } else { const int j = n - 16, bh = x + 8 * (j >> 4), qb = j & 15;
            da::attn_unit((char*)lds_generic, P + G_QD * GSTRIDE, P + G_KD * GSTRIDE, P + G_VD * GSTRIDE, MIXED, F.in[11], bh >> 3, bh & 7, qb, lam);
        }
    }
}

__device__ __forceinline__ void p3b_combine(Frame& F) {
    const int tid = opaque_tid(), lane = tid & 63, wave = __builtin_amdgcn_readfirstlane(tid >> 6); (void)lane; (void)wave;
    const float* OF = F.out; const float* OB = F.out + (size_t)ML * GW;
    const bf16* GH = (const bf16*)(F.ws + WS_P) + G_GH * GSTRIDE;
    bf16* MIXED = (bf16*)(F.ws + WS_XM);
    const float* hw = F.in[14];
    const int gw = F.vcu * NWAVES + wave, NGW = F.G * NWAVES, c0 = 16 * lane;
    f32x4 w4[4];
#pragma unroll
    for (int i = 0; i < 4; ++i) w4[i] = *(const GAS f32x4*)(hw + (c0 & 127) + 4 * i);
    for (int row = gw; row < ML; row += NGW) {
        f32x4 o[4]; float ss = 0.f;
#pragma unroll
        for (int i = 0; i < 4; ++i) { o[i] = *(const GAS f32x4*)(OF + (size_t)row * GW + c0 + 4 * i) + *(const GAS f32x4*)(OB + (size_t)row * GW + c0 + 4 * i);
            ss += (o[i][0] * o[i][0] + o[i][1] * o[i][1]) + (o[i][2] * o[i][2] + o[i][3] * o[i][3]); }
        ss += __shfl_xor(ss, 1); ss += __shfl_xor(ss, 2); ss += __shfl_xor(ss, 4);
        const float rs = 1.f / sqrtf(ss * (1.f / 128.f) + LN_EPS);
        const v4u g0 = *(const GAS v4u*)(GH + (size_t)row * GW + c0), g1 = *(const GAS v4u*)(GH + (size_t)row * GW + c0 + 8);
        const unsigned gw_[8] = {g0.x, g0.y, g0.z, g0.w, g1.x, g1.y, g1.z, g1.w};
        unsigned ow[8];
#pragma unroll
        for (int i = 0; i < 4; ++i) {
            const float a0 = o[i][0] * rs * w4[i][0] * bf_lo(gw_[2 * i]), a1 = o[i][1] * rs * w4[i][1] * bf_hi(gw_[2 * i]);
            const float a2 = o[i][2] * rs * w4[i][2] * bf_lo(gw_[2 * i + 1]), a3 = o[i][3] * rs * w4[i][3] * bf_hi(gw_[2 * i + 1]);
            ow[2 * i] = pk2(a0, a1); ow[2 * i + 1] = pk2(a2, a3); }
        bf16* op = MIXED + (size_t)row * DM + GW + c0;
        *(GAS v4u*)op = (v4u){ow[0], ow[1], ow[2], ow[3]}; *(GAS v4u*)(op + 8) = (v4u){ow[4], ow[5], ow[6], ow[7]};
    }
}

template <bool WITH_U>
__device__ __forceinline__ void ln_pass(Frame& F, const float* g, const float* bta) {
    const int tid = opaque_tid(), lane = tid & 63, wave = __builtin_amdgcn_readfirstlane(tid >> 6); (void)lane; (void)wave;
    const float* M_ADA = (const float*)(F.ws + WS_SMALL + SM_ADA);
    bf16* U = (bf16*)(F.ws + WS_U);
    const int gw = F.vcu * NWAVES + wave, NGW = F.G * NWAVES;
    for (int row = gw; row < ML; row += NGW) {
        GAS f32x4* xr = (GAS f32x4*)(F.out + (size_t)row * DM) + lane;
        f32x4 v[8]; float s = 0.f;
#pragma unroll
        for (int j = 0; j < 8; ++j) { v[j] = xr[64 * j]; s += (v[j][0] + v[j][1]) + (v[j][2] + v[j][3]); }
        const float mean = wave_sum(s) * (1.f / DM); float s2 = 0.f;
#pragma unroll
        for (int j = 0; j < 8; ++j) { v[j] = v[j] - mean; s2 += (v[j][0] * v[j][0] + v[j][1] * v[j][1]) + (v[j][2] * v[j][2] + v[j][3] * v[j][3]); }
        const float rstd = 1.f / sqrtf(wave_sum(s2) * (1.f / DM) + LN_EPS);
        const float* sh = M_ADA + (size_t)(row >> 11) * NADA + 3 * DM; const float* sc = sh + DM;
        GAS v2u* o8 = (GAS v2u*)(U + (size_t)row * DM) + lane;
#pragma unroll
        for (int j = 0; j < 8; ++j) { const int col = 4 * lane + 256 * j;
            const f32x4 hv = v[j] * rstd * *(const GAS f32x4*)(g + col) + *(const GAS f32x4*)(bta + col);
            xr[64 * j] = hv;
            if (WITH_U) { const f32x4 y = hv * (*(const GAS f32x4*)(sc + col) + 1.f) + *(const GAS f32x4*)(sh + col);
                v2u w; w.x = pk2(y[0], y[1]); w.y = pk2(y[2], y[3]); o8[64 * j] = w; } }
    }
}

struct Args { const float* in[22]; float* out; unsigned char* ws; };
__global__ void __launch_bounds__(NWAVES * 64, 2) mega_fwd(Args args) {
    extern __shared__ __attribute__((aligned(16))) unsigned char lds[];
    Frame F;
    F.lds = (LAS unsigned char*)lds;
    F.MISC = (volatile LAS unsigned*)(F.lds + LDSCTL_OFF);
    const int tid = threadIdx.x;
    F.G = gridDim.x; { const int bx = blockIdx.x; F.vcu = (F.G % 8 == 0) ? (bx % 8) * (F.G / 8) + bx / 8 : bx; }
    F.ws = args.ws; F.out = args.out; F.ctl = (gu32*)(args.ws + WS_CTL);
#pragma unroll
    for (int i = 0; i < 22; ++i) F.in[i] = args.in[i];
    for (int u = tid; u < (LDS_BYTES - LDSCTL_OFF) / 4; u += NWAVES * 64) ((LAS unsigned*)(F.lds + LDSCTL_OFF))[u] = 0u;
    __syncthreads();
    XcdBarrier bar = xcd_barrier_post((unsigned*)(F.ctl + CW_BAR), F.MISC + 8);
#ifdef PROBE_PA
    int n_stamp = 0;
#define GRID_BAR() do { xcd_barrier(bar); if (blockIdx.x == 0 && tid == 0) { F.ctl[CW_TS + 2 * n_stamp] = (unsigned)__builtin_amdgcn_s_memrealtime(); } ++n_stamp; } while (0)
    if (blockIdx.x == 0 && tid == 0) F.ctl[CW_TS + 2 * 15] = (unsigned)__builtin_amdgcn_s_memrealtime();
#else
#define GRID_BAR() xcd_barrier(bar)
#endif
    const float* M_ADA = (const float*)(F.ws + WS_SMALL + SM_ADA);

    p0_prologue(F); GRID_BAR();
    p1_prep(F); GRID_BAR();
    {
        pg8::Gemm g{(const pg8::bf16_t*)(F.ws + WS_XM), (const pg8::bf16_t*)(F.ws + WS_WIN), MT, NIN, DM}; pg8::StaticOrder S; S.init(MT, NIN, F.G, (int)blockIdx.x);
        pg8::EpiInProj E{(pg8::bf16_t*)(F.ws + WS_P), (const float*)(F.ws + WS_SMALL + SM_ROPE), (const float*)(F.ws + WS_SMALL + SM_LBF), (const float*)(F.ws + WS_SMALL + SM_LBB)};
        pg8::gemm_phase<pg8::EpiInProj, pg8::StaticOrder, true, true>(F.lds, g, S, E);
    }
    GRID_BAR();
    p3_mixer(F, lds, bar.x & 7u); GRID_BAR();
    p3b_combine(F); GRID_BAR();
    {
        pg8::Gemm g{(const pg8::bf16_t*)(F.ws + WS_XM), (const pg8::bf16_t*)(F.ws + WS_WOUT), ML, DM, DM}; pg8::StaticOrder S; S.init(ML, DM, F.G, (int)blockIdx.x);
        pg8::EpiResid E{F.in[0], F.out, M_ADA + 2 * DM};
        pg8::gemm_phase<pg8::EpiResid, pg8::StaticOrder, true, true>(F.lds, g, S, E);
    }
    GRID_BAR();
    ln_pass<true>(F, F.in[16], F.in[17]); GRID_BAR();
    {
        pg8::Gemm g{(const pg8::bf16_t*)(F.ws + WS_U), (const pg8::bf16_t*)(F.ws + WS_WFF1), ML, DFF, DM}; pg8::StaticOrder S; S.init(ML, DFF, F.G, (int)blockIdx.x);
        pg8::EpiRelu2 E{(pg8::bf16_t*)(F.ws + WS_H), DFF};
        pg8::gemm_phase<pg8::EpiRelu2, pg8::StaticOrder, true, true>(F.lds, g, S, E);
    }
    GRID_BAR();
    {
        pg8::Gemm g{(const pg8::bf16_t*)(F.ws + WS_H), (const pg8::bf16_t*)(F.ws + WS_WFF2), ML, DM, DFF}; pg8::StaticOrder S; S.init(ML, DM, F.G, (int)blockIdx.x);
        pg8::EpiResid E{F.out, F.out, M_ADA + 5 * DM};
        pg8::gemm_phase<pg8::EpiResid, pg8::StaticOrder, true, true>(F.lds, g, S, E);
    }
    GRID_BAR();
    ln_pass<false>(F, F.in[20], F.in[21]);
#ifdef PROBE_PA
    GRID_BAR();
    if (blockIdx.x == 0 && tid == 0) {
        unsigned ts[11]; ts[0] = F.ctl[CW_TS + 30];
#pragma unroll
        for (int k = 0; k < 10; ++k) ts[k + 1] = F.ctl[CW_TS + 2 * k];
        F.out[0] += 0.01f * (float)(ts[PROBE_PA + 1] - ts[PROBE_PA]);
        F.out[1] += 0.01f * (float)(ts[PROBE_PB + 1] - ts[PROBE_PB]);
    }
#endif
#undef GRID_BAR
}

extern "C" void kernel_launch(void* const* d_in, const int* in_sizes, int n_in, void* d_out, int out_size, void* d_ws, size_t ws_size, hipStream_t stream) {
    static int grid = 0;
    if (grid == 0) {
        if (n_in != 22 || in_sizes[0] != ML * DM || out_size != ML * DM || ws_size < WS_END) {
            fprintf(stderr, "kernel_launch: built for 22 inputs, x and out of %d floats, >= %zu bytes of workspace; got n_in %d, in0 %d, out %d, ws %zu; nothing launched\n", ML * DM, (size_t)WS_END, n_in, n_in > 0 ? in_sizes[0] : -1, out_size, ws_size); grid = -1; return; }
        int dev = 0, cus = 0, per_cu = 0;
        if (hipGetDevice(&dev) != hipSuccess || hipDeviceGetAttribute(&cus, hipDeviceAttributeMultiprocessorCount, dev) != hipSuccess) { fprintf(stderr, "kernel_launch: device query failed\n"); grid = -1; return; }
        if (hipFuncSetAttribute((const void*)mega_fwd, hipFuncAttributeMaxDynamicSharedMemorySize, LDS_BYTES) != hipSuccess) { fprintf(stderr, "kernel_launch: hipFuncSetAttribute failed\n"); grid = -1; return; }
        if (hipOccupancyMaxActiveBlocksPerMultiprocessor(&per_cu, (const void*)mega_fwd, NWAVES * 64, LDS_BYTES) != hipSuccess || per_cu < 1)
            fprintf(stderr, "kernel_launch: note: occupancy query reports %d workgroups per CU\n", per_cu);
        (void)hipGetLastError();
        grid = cus;
        if (grid % 8 != 0) grid -= grid % 8;
    }
    if (grid < 0) return;
    if (hipMemsetAsync((char*)d_ws + WS_CTL, 0, CTL_ZERO_BYTES, stream) != hipSuccess) { fprintf(stderr, "kernel_launch: hipMemsetAsync failed\n"); return; }
    Args a{};
    for (int i = 0; i < 22; ++i) a.in[i] = (const float*)d_in[i];
    a.out = (float*)d_out; a.ws = (unsigned char*)d_ws;
    hipLaunchKernelGGL(mega_fwd, dim3(grid), dim3(NWAVES * 64), LDS_BYTES, stream, a);
    const hipError_t le = hipPeekAtLastError();
    if (le != hipSuccess) fprintf(stderr, "kernel_launch: launch failed: %s\n", hipGetErrorName(le));
}
```
